# Optimizing an MI355X kernel written in HIP

```python
import jax, jax.numpy as jnp
from jax import lax
import numpy as np

D_MODEL = 2048
BATCH = 2
SEQ = 4096
DEPTH = 1

HEAD_DIM = 128
HEADS_PER_GROUP = 8
DILATED_GROUPS = ((128, 1), (512, 4), (2048, 16))
N_ATTN_GROUPS = len(DILATED_GROUPS)
ATTN_QKV = N_ATTN_GROUPS * HEADS_PER_GROUP * HEAD_DIM
ATTN_OUT = HEADS_PER_GROUP * HEAD_DIM
BLK = 128
ROPE_THETA = 500000.0
ROT_DIM = HEAD_DIM // 4
POOL_SIZES = (2, 4, 8, 16)
POOL_WIDTH = D_MODEL // 2
POOL_GROUP = POOL_WIDTH // len(POOL_SIZES)
IN_COLS = 3 * ATTN_QKV + ATTN_OUT + 2 * POOL_WIDTH + 2 * D_MODEL
NORM_EPS = 1e-6

kernel_name = "hybrid_dilated_attn_pool_gated_merge"


def rms_norm(x, g):
    xf = x.astype(jnp.float32)
    y = xf * lax.rsqrt(jnp.mean(xf * xf, axis=-1, keepdims=True) + NORM_EPS)
    return (y * g.astype(jnp.float32)).astype(x.dtype)


def partial_rope(t, pos):
    half = ROT_DIM // 2
    inv_freq = ROPE_THETA ** (-jnp.arange(0, ROT_DIM, 2, dtype=jnp.float32) / ROT_DIM)
    ang = pos.astype(jnp.float32)[:, None] * inv_freq[None, :]
    cos = jnp.concatenate([jnp.cos(ang), jnp.cos(ang)], axis=-1)[None, :, None, :]
    sin = jnp.concatenate([jnp.sin(ang), jnp.sin(ang)], axis=-1)[None, :, None, :]
    tr = t[..., :ROT_DIM].astype(jnp.float32)
    rot_half = jnp.concatenate([-tr[..., half:], tr[..., :half]], axis=-1)
    tr = (tr * cos + rot_half * sin).astype(t.dtype)
    return jnp.concatenate([tr, t[..., ROT_DIM:]], axis=-1)


def dilated_window_attention(q, k, v, window, dilation):
    B, S, H, C = q.shape
    w_sub = window // dilation
    L = S // dilation
    nb = -(-L // BLK)
    Lp = nb * BLK

    def to_blocks(t):
        t = t.reshape(B, L, dilation, H, C).transpose(0, 2, 1, 3, 4)
        t = jnp.pad(t, ((0, 0), (0, 0), (0, Lp - L), (0, 0), (0, 0)))
        return t.reshape(B, dilation, nb, BLK, H, C)

    def with_prev(t):
        prev = jnp.pad(t, ((0, 0), (0, 0), (1, 0), (0, 0), (0, 0), (0, 0)))[:, :, :nb]
        return jnp.concatenate([prev, t], axis=3)

    qb = to_blocks(q)
    kk = with_prev(to_blocks(k))
    vv = with_prev(to_blocks(v))
    s = jnp.einsum('brnqhc,brnkhc->brnhqk', qb, kk).astype(jnp.float32) * (C ** -0.5)
    blk = jnp.arange(nb)[:, None, None]
    qpos = blk * BLK + jnp.arange(BLK)[None, :, None]
    kpos = (blk - 1) * BLK + jnp.arange(2 * BLK)[None, None, :]
    dist = qpos - kpos
    mask = (kpos >= 0) & (dist >= 0) & (dist <= w_sub)
    s = jnp.where(mask[None, None, :, None], s, -jnp.inf)
    lse = jax.nn.logsumexp(s, axis=-1)
    p = jnp.exp(s - lse[..., None])
    o = jnp.einsum('brnhqk,brnkhc->brnqhc', p.astype(v.dtype), vv)
    o = o.reshape(B, dilation, Lp, H, C)[:, :, :L].transpose(0, 2, 1, 3, 4).reshape(B, S, H, C)
    lse = lse.transpose(0, 1, 2, 4, 3).reshape(B, dilation, Lp, H)[:, :, :L]
    lse = lse.transpose(0, 2, 1, 3).reshape(B, S, H)
    return o, lse


def causal_mean(u, k):
    S = u.shape[1]
    cs = jnp.cumsum(u.astype(jnp.float32), axis=1)
    prev = jnp.pad(cs, ((0, 0), (k, 0), (0, 0)))[:, :S]
    cnt = jnp.minimum(jnp.arange(S) + 1, k).astype(jnp.float32)
    return (cs - prev) / cnt[None, :, None]


def setup_inputs(seed: int = 0) -> dict:
    key = jax.random.key(seed)
    ks = jax.random.split(key, 12)
    f = jnp.float32
    x = jax.random.normal(ks[0], (BATCH, SEQ, D_MODEL), f)
    norm_gain = 1.0 + 0.02 * jax.random.normal(ks[1], (D_MODEL,), f)
    w_in = jax.random.normal(ks[2], (D_MODEL, IN_COLS), f) * D_MODEL ** -0.5
    b_gates = 0.02 * jax.random.normal(ks[3], (2 * D_MODEL,), f)
    q_norm_gain = 1.0 + 0.02 * jax.random.normal(ks[4], (HEAD_DIM,), f)
    k_norm_gain = 1.0 + 0.02 * jax.random.normal(ks[5], (HEAD_DIM,), f)
    pool_maps = jax.random.normal(ks[6], (len(POOL_SIZES), POOL_GROUP, POOL_GROUP), f) * POOL_GROUP ** -0.5
    pool_scale = 1.0 + 0.1 * jax.random.normal(ks[7], (POOL_WIDTH,), f)
    w_branch_attn = jax.random.normal(ks[8], (ATTN_OUT, D_MODEL), f) * ATTN_OUT ** -0.5
    w_branch_pool = jax.random.normal(ks[9], (POOL_WIDTH, D_MODEL), f) * POOL_WIDTH ** -0.5
    w_out = jax.random.normal(ks[10], (D_MODEL, D_MODEL), f) * D_MODEL ** -0.5
    return {"x": x, "norm_gain": norm_gain, "w_in": w_in, "b_gates": b_gates,
            "q_norm_gain": q_norm_gain, "k_norm_gain": k_norm_gain,
            "pool_maps": pool_maps, "pool_scale": pool_scale,
            "w_branch_attn": w_branch_attn, "w_branch_pool": w_branch_pool, "w_out": w_out}


def reference(x, norm_gain, w_in, b_gates, q_norm_gain, k_norm_gain, pool_maps, pool_scale,
              w_branch_attn, w_branch_pool, w_out):
    B, S, _ = x.shape
    pos = jnp.arange(S, dtype=jnp.int32)
    for _layer in range(DEPTH):
        h = rms_norm(x, norm_gain)
        proj = jnp.einsum('bsd,de->bse', h, w_in)
        splits = np.cumsum([ATTN_QKV, ATTN_QKV, ATTN_QKV, ATTN_OUT, POOL_WIDTH, POOL_WIDTH]).tolist()
        q, k, v, z_attn, u_pool, z_pool, gates = jnp.split(proj, splits, axis=-1)
        shp = (B, S, N_ATTN_GROUPS, HEADS_PER_GROUP, HEAD_DIM)
        q = rms_norm(q.reshape(shp), q_norm_gain)
        k = rms_norm(k.reshape(shp), k_norm_gain)
        v = v.reshape(shp)

        outs, lses = [], []
        for g, (window, dilation) in enumerate(DILATED_GROUPS):
            qg = partial_rope(q[:, :, g], pos)
            kg = partial_rope(k[:, :, g], pos)
            o_g, lse_g = dilated_window_attention(qg, kg, v[:, :, g], window, dilation)
            outs.append(o_g)
            lses.append(lse_g)
        mix_w = jax.nn.softmax(jnp.stack(lses, axis=0), axis=0)
        attn = jnp.sum(mix_w[..., None] * jnp.stack(outs, axis=0).astype(jnp.float32), axis=0)
        attn = attn.astype(x.dtype).reshape(B, S, ATTN_OUT)
        y_attn = jnp.einsum('bsc,cd->bsd', attn * jax.nn.silu(z_attn), w_branch_attn)

        pooled = []
        for g, ksz in enumerate(POOL_SIZES):
            u_g = u_pool[..., g * POOL_GROUP:(g + 1) * POOL_GROUP]
            d_g = (causal_mean(u_g, ksz) - u_g.astype(jnp.float32)).astype(x.dtype)
            pooled.append(jnp.einsum('bsc,ce->bse', d_g, pool_maps[g]))
        pool = jnp.concatenate(pooled, axis=-1) * pool_scale
        y_pool = jnp.einsum('bsc,cd->bsd', pool * jax.nn.silu(z_pool), w_branch_pool)

        gate = jax.nn.sigmoid((gates + b_gates).astype(jnp.float32)).astype(x.dtype)
        g_attn, g_pool = jnp.split(gate, 2, axis=-1)
        merged = g_attn * y_attn + g_pool * y_pool
        x = x + jnp.einsum('bsd,de->bse', merged, w_out)
    return x
```

```cpp
#include <hip/hip_runtime.h>
#include <hip/hip_cooperative_groups.h>
#include <cstdio>
#include <cstdint>
namespace cg = cooperative_groups;

#ifndef MK_N_LAUNCHES
#define MK_N_LAUNCHES 6
#endif

#define LAS __attribute__((address_space(3)))
typedef unsigned short bf16_t;
typedef short bf16x8 __attribute__((ext_vector_type(8)));
typedef short v4i16_t __attribute__((ext_vector_type(4)));
typedef float f32x4 __attribute__((ext_vector_type(4)));
typedef unsigned u32x4 __attribute__((ext_vector_type(4)));
typedef unsigned u32x2 __attribute__((ext_vector_type(2)));

constexpr int BATCH = 2, SEQ = 4096, DM = 2048, M = BATCH * SEQ, INC = 16384, HD = 128;
constexpr int C_Q = 0, C_K = 3072, C_V = 6144, C_ZA = 9216, C_U = 10240, C_ZP = 11264, C_G = 12288;
constexpr float NORM_EPS = 1e-6f;
constexpr int NTHREADS = 512, NWAVES = 8;

constexpr size_t MiB = 1u << 20;
constexpr size_t WS_CTL = 0;
constexpr size_t WS_WIN = 2 * MiB;
constexpr size_t WS_W12 = 66 * MiB;
constexpr size_t WS_WO = 74 * MiB;
constexpr size_t WS_PM = 82 * MiB;
constexpr size_t WS_ROPE = 83 * MiB;
constexpr size_t WS_XN = 84 * MiB;
constexpr size_t WS_PROJ = 116 * MiB;
constexpr size_t WS_O = 372 * MiB;
constexpr size_t WS_LSE = 420 * MiB;
constexpr size_t WS_D = 422 * MiB;
constexpr size_t WS_A12 = 438 * MiB;
constexpr size_t WS_MG = 470 * MiB;
constexpr size_t WS_END = 502 * MiB;

constexpr int LDS_BYTES = 150 * 1024;

__device__ __forceinline__ unsigned cvt_pk_bf16(float lo, float hi) { unsigned r; asm volatile("v_cvt_pk_bf16_f32 %0, %1, %2" : "=v"(r) : "v"(lo), "v"(hi)); return r; }
__device__ __forceinline__ float bf_lo(unsigned w) { return __uint_as_float(w << 16); }
__device__ __forceinline__ float bf_hi(unsigned w) { return __uint_as_float(w & 0xffff0000u); }
__device__ __forceinline__ float fast_sigmoid(float v) { return __builtin_amdgcn_rcpf(1.0f + __builtin_amdgcn_exp2f(-1.4426950408889634f * v)); }
__device__ __forceinline__ void unpack8(const u32x4 w, float (&v)[8]) {
    v[0] = bf_lo(w.x); v[1] = bf_hi(w.x); v[2] = bf_lo(w.y); v[3] = bf_hi(w.y); v[4] = bf_lo(w.z); v[5] = bf_hi(w.z); v[6] = bf_lo(w.w); v[7] = bf_hi(w.w);
}
__device__ __forceinline__ u32x4 pack8(const float (&v)[8]) {
    u32x4 w; w.x = cvt_pk_bf16(v[0], v[1]); w.y = cvt_pk_bf16(v[2], v[3]); w.z = cvt_pk_bf16(v[4], v[5]); w.w = cvt_pk_bf16(v[6], v[7]); return w;
}

namespace pg8 {
constexpr int BM = 256, BK = 64, HALF = 128, HTB = HALF * BK * 2, STAGE_BYTES = 8 * HTB, NXCD = 8, WGM = 8;
__host__ __device__ __forceinline__ int lds_byte(int r, int c) { const int st = (r >> 4) * 2 + (c >> 5), rr = r & 15, cc = c & 31, ob = rr * 64 + cc * 2; return st * 1024 + (ob ^ (((ob >> 9) & 1) << 5)); }
__host__ __device__ __forceinline__ void stage_rc(int b, int& R, int& C) { const int st = b / 1024, sb = b % 1024, swz = sb ^ (((sb >> 9) & 1) << 5); R = (st >> 1) * 16 + swz / 64; C = (st & 1) * 32 + (swz % 64) / 2; }
__host__ __device__ __forceinline__ int perm32(int rho) { const int n = rho >> 4, i = rho & 15; return 8 * (i >> 2) + 4 * n + (i & 3); }

struct Unit { int pm, pn, acol, bcol, tag, keep; };
struct Gemm { const bf16_t* A; const bf16_t* Bt; int lda, ldb, K; };

__device__ __forceinline__ void tile_of(int L, int nM, int nN, int& pm, int& pn) {
    const int nwg = nM * nN; int wgid = L;
    { const int q = nwg / NXCD, r = nwg % NXCD, xcd = wgid % NXCD, off = wgid / NXCD; wgid = (xcd < r ? xcd * (q + 1) : r * (q + 1) + (xcd - r) * q) + off; }
    const int nig = WGM * nN, gid = wgid / nig, fm = gid * WGM, gsz = (nM - fm) < WGM ? (nM - fm) : WGM;
    pm = fm + ((wgid % nig) % gsz); pn = (wgid % nig) / gsz;
}
struct SchedStd {
    int nM, nN, G, c;
    __device__ __forceinline__ bool next(int i, Unit& u) const { const long L = (long)i * G + c; if (L >= (long)nM * nN) return false; tile_of((int)L, nM, nN, u.pm, u.pn); u.acol = 0; u.bcol = 0; u.tag = 0; u.keep = 0; return true; }
};
struct SchedPool {
    int G, c;
    __device__ __forceinline__ bool next(int i, Unit& u) const { const int L = i * G + c; if (L >= 128) return false; u.pm = L >> 2; u.pn = L & 3; u.acol = u.pn * 256; u.bcol = 0; u.tag = 0; u.keep = 0; return true; }
};
struct SchedDual {
    int nM, nN, G, c;
    __device__ __forceinline__ bool next(int i, Unit& u) const { const long L = (long)(i >> 1) * G + c; if (L >= (long)nM * nN) return false; tile_of((int)L, nM, nN, u.pm, u.pn); u.tag = i & 1; u.acol = u.bcol = u.tag * 1024; u.keep = (u.tag == 0); return true; }
};

template <class Epi, class Sched, bool ALIGN_EPI>
__device__ __forceinline__ void gemm_phase(LAS unsigned char* lds, const Gemm g, const Sched& S, const Epi& E) {
    const int tid = threadIdx.x, wid = __builtin_amdgcn_readfirstlane(tid >> 6), lane = tid & 63, wr = wid >> 2, wc = wid & 3, fr = lane & 15, fq = lane >> 4;
    const int nt = g.K / BK;
    unsigned voffA[2], voffB[2];
#pragma unroll
    for (int i = 0; i < 2; ++i) { int R, C; stage_rc(tid * 16 + i * 8192, R, C); const int Rb = Epi::PERM ? ((R & ~31) + perm32(R & 31)) : R;
        voffA[i] = (unsigned)(R * g.lda + C) * 2u; voffB[i] = (unsigned)(Rb * g.ldb + C) * 2u; }
    const size_t kstep = (size_t)(BK * 2);
    const size_t hsA = (size_t)HALF * g.lda * 2, hsB = (size_t)HALF * g.ldb * 2;
    const unsigned ldsw = (unsigned)wid * 1024u;
    const int aoff = lds_byte(wr * 64 + fr, fq * 8), boff = lds_byte(wc * 32 + fr, fq * 8);
#define PG8_SA(b, h) (((b) * 2 + (h)) * HTB)
#define PG8_SB(b, h) ((4 + (b) * 2 + (h)) * HTB)
#define PG8_STAGE(bufoff, gbase, voff) do { _Pragma("unroll") for (int _i = 0; _i < 2; ++_i) \
        __builtin_amdgcn_global_load_lds((const unsigned*)((const char*)(gbase) + (voff)[_i]), (LAS unsigned*)(lds + (bufoff) + ldsw + _i * 8192), 16, 0, 0); } while (0)
#define PG8_LDA(dst, b, h) do { _Pragma("unroll") for (int m = 0; m < 4; ++m) _Pragma("unroll") for (int k = 0; k < 2; ++k) dst[m][k] = *(const LAS bf16x8*)(lds + PG8_SA(b, h) + aoff + m * 2048 + k * 1024); } while (0)
#define PG8_LDB(dst, b, h) do { _Pragma("unroll") for (int n = 0; n < 2; ++n) _Pragma("unroll") for (int k = 0; k < 2; ++k) dst[n][k] = *(const LAS bf16x8*)(lds + PG8_SB(b, h) + boff + n * 2048 + k * 1024); } while (0)
#define PG8_MMA(ai, bj, At, Bt) do { __builtin_amdgcn_s_setprio(1); _Pragma("unroll") for (int m = 0; m < 4; ++m) _Pragma("unroll") for (int n = 0; n < 2; ++n) _Pragma("unroll") for (int k = 0; k < 2; ++k) \
        acc[ai][bj][m][n] = __builtin_amdgcn_mfma_f32_16x16x32_bf16(Bt[n][k], At[m][k], acc[ai][bj][m][n], 0, 0, 0); __builtin_amdgcn_s_setprio(0); } while (0)
#define PG8_WAIT_V(n) asm volatile("s_waitcnt vmcnt(" #n ")" ::: "memory")
#define PG8_WAIT_L(n) asm volatile("s_waitcnt lgkmcnt(" #n ")" ::: "memory")
#define PG8_BAR __builtin_amdgcn_s_barrier()
#define PG8_SCHED __builtin_amdgcn_sched_barrier(0)
    Unit cur, nxt; int ui = 0;
    if (!S.next(0, cur)) return;
    f32x4 acc[2][2][4][2];
#pragma unroll
    for (int a = 0; a < 2; ++a)
#pragma unroll
        for (int b = 0; b < 2; ++b)
#pragma unroll
            for (int m = 0; m < 4; ++m)
#pragma unroll
                for (int n = 0; n < 2; ++n) acc[a][b][m][n] = (f32x4){0.f, 0.f, 0.f, 0.f};
    bf16x8 At[4][2], B0[2][2], B1[2][2];
    const char* cA = (const char*)g.A + ((size_t)cur.pm * BM * g.lda + cur.acol) * 2; const char* cB = (const char*)g.Bt + ((size_t)cur.pn * BM * g.ldb + cur.bcol) * 2;
    PG8_STAGE(PG8_SB(0, 0), cB, voffB); PG8_STAGE(PG8_SB(0, 1), cB + hsB, voffB); PG8_STAGE(PG8_SA(0, 0), cA, voffA); PG8_STAGE(PG8_SA(0, 1), cA + hsA, voffA);
    if (wr == 1) PG8_BAR;
    PG8_WAIT_V(2); PG8_BAR;
    PG8_STAGE(PG8_SB(1, 0), cB + kstep, voffB); PG8_STAGE(PG8_SA(1, 0), cA + kstep, voffA); PG8_STAGE(PG8_SB(1, 1), cB + hsB + kstep, voffB);
    PG8_WAIT_V(6); PG8_BAR;
    for (;;) {
        const bool has_next = S.next(ui + 1, nxt);
        const char* nA = has_next ? (const char*)g.A + ((size_t)nxt.pm * BM * g.lda + nxt.acol) * 2 : cA; const char* nB = has_next ? (const char*)g.Bt + ((size_t)nxt.pn * BM * g.ldb + nxt.bcol) * 2 : cB;
        for (int t = 0; t < nt; t += 2) {
            const bool last = (t == nt - 2);
            const char* a1 = cA + (size_t)(t + 1) * kstep;
            const char* a2 = last ? nA : cA + (size_t)(t + 2) * kstep; const char* b2 = last ? nB : cB + (size_t)(t + 2) * kstep;
            const char* a3 = a2 + kstep; const char* b3 = b2 + kstep;
            PG8_LDB(B0, 0, 0); PG8_LDB(B1, 0, 1); PG8_SCHED; PG8_LDA(At, 0, 0); PG8_STAGE(PG8_SA(1, 1), a1 + hsA, voffA);
            PG8_WAIT_V(8); PG8_WAIT_L(0); PG8_BAR; PG8_MMA(0, 0, At, B0); PG8_MMA(0, 1, At, B1); PG8_BAR; PG8_SCHED;
            PG8_LDA(At, 0, 1); PG8_STAGE(PG8_SB(0, 0), b2, voffB); PG8_STAGE(PG8_SB(0, 1), b2 + hsB, voffB); PG8_STAGE(PG8_SA(0, 0), a2, voffA);
            PG8_WAIT_V(8); PG8_WAIT_L(0); PG8_BAR; PG8_MMA(1, 0, At, B0); PG8_MMA(1, 1, At, B1); PG8_BAR; PG8_SCHED;
            PG8_LDB(B0, 1, 0); PG8_LDB(B1, 1, 1); PG8_SCHED; PG8_LDA(At, 1, 0); PG8_STAGE(PG8_SA(0, 1), a2 + hsA, voffA);
            PG8_WAIT_V(8); PG8_WAIT_L(0); PG8_BAR; PG8_MMA(0, 0, At, B0); PG8_MMA(0, 1, At, B1); PG8_BAR; PG8_SCHED;
            PG8_LDA(At, 1, 1); PG8_STAGE(PG8_SB(1, 0), b3, voffB); PG8_STAGE(PG8_SB(1, 1), b3 + hsB, voffB); PG8_STAGE(PG8_SA(1, 0), a3, voffA);
            PG8_WAIT_V(8); PG8_WAIT_L(0); PG8_BAR; PG8_MMA(1, 0, At, B0); PG8_MMA(1, 1, At, B1); PG8_BAR; PG8_SCHED;
        }
        if constexpr (ALIGN_EPI) { if (wr == 0) PG8_BAR; }
        E(acc, cur, wr, wc, fr, fq);
        if (!has_next) break;
        if (!cur.keep) {
#pragma unroll
            for (int a = 0; a < 2; ++a)
#pragma unroll
                for (int b = 0; b < 2; ++b)
#pragma unroll
                    for (int m = 0; m < 4; ++m)
#pragma unroll
                        for (int n = 0; n < 2; ++n) acc[a][b][m][n] = (f32x4){0.f, 0.f, 0.f, 0.f};
        }
        cur = nxt; cA = nA; cB = nB; ++ui;
        if constexpr (ALIGN_EPI) { if (wr == 1) PG8_BAR; }
    }
    PG8_WAIT_V(0);
    if constexpr (!ALIGN_EPI) { if (wr == 0) PG8_BAR; }
    PG8_BAR;
#undef PG8_SA
#undef PG8_SB
#undef PG8_STAGE
#undef PG8_LDA
#undef PG8_LDB
#undef PG8_MMA
#undef PG8_WAIT_V
#undef PG8_WAIT_L
#undef PG8_BAR
#undef PG8_SCHED
}

struct EpiProj {
    static constexpr bool PERM = true;
    bf16_t* O; const float* bg;
    __device__ __forceinline__ void operator()(f32x4 (&acc)[2][2][4][2], const Unit& u, int wr, int wc, int fr, int fq) const {
        const int row0 = u.pm * BM + wr * 64 + fr, col0 = u.pn * BM + wc * 32 + 8 * fq;
        const int mode = (u.pn >= 48) ? 2 : (((u.pn >= 36 && u.pn < 40) || (u.pn >= 44)) ? 1 : 0);
        f32x4 bv[2][2];
#pragma unroll
        for (int bj = 0; bj < 2; ++bj)
#pragma unroll
            for (int n = 0; n < 2; ++n) bv[bj][n] = (mode == 2) ? *(const f32x4*)(bg + (col0 - C_G) + bj * HALF + 4 * n) : (f32x4){0.f, 0.f, 0.f, 0.f};
#pragma unroll
        for (int ai = 0; ai < 2; ++ai)
#pragma unroll
            for (int m = 0; m < 4; ++m) { bf16_t* rowp = O + (size_t)(row0 + ai * HALF + m * 16) * INC + col0;
#pragma unroll
                for (int bj = 0; bj < 2; ++bj) { f32x4 v0 = acc[ai][bj][m][0] + bv[bj][0], v1 = acc[ai][bj][m][1] + bv[bj][1];
                    if (mode == 1) {
#pragma unroll
                        for (int e = 0; e < 4; ++e) { v0[e] = v0[e] * fast_sigmoid(v0[e]); v1[e] = v1[e] * fast_sigmoid(v1[e]); }
                    } else if (mode == 2) {
#pragma unroll
                        for (int e = 0; e < 4; ++e) { v0[e] = fast_sigmoid(v0[e]); v1[e] = fast_sigmoid(v1[e]); }
                    }
                    u32x4 w; w.x = cvt_pk_bf16(v0[0], v0[1]); w.y = cvt_pk_bf16(v0[2], v0[3]); w.z = cvt_pk_bf16(v1[0], v1[1]); w.w = cvt_pk_bf16(v1[2], v1[3]);
                    *(u32x4*)(rowp + bj * HALF) = w; } }
    }
};
struct EpiPool {
    static constexpr bool PERM = true;
    bf16_t* O; const bf16_t* proj; const float* ps;
    __device__ __forceinline__ void operator()(f32x4 (&acc)[2][2][4][2], const Unit& u, int wr, int wc, int fr, int fq) const {
        const int row0 = u.pm * BM + wr * 64 + fr, col0 = u.pn * BM + wc * 32 + 8 * fq;
        f32x4 sv[2][2];
#pragma unroll
        for (int bj = 0; bj < 2; ++bj)
#pragma unroll
            for (int n = 0; n < 2; ++n) sv[bj][n] = *(const f32x4*)(ps + col0 + bj * HALF + 4 * n);
#pragma unroll
        for (int ai = 0; ai < 2; ++ai)
#pragma unroll
            for (int m = 0; m < 4; ++m) { const size_t row = (size_t)(row0 + ai * HALF + m * 16);
#pragma unroll
                for (int bj = 0; bj < 2; ++bj) { const u32x4 z = *(const u32x4*)(proj + row * INC + C_ZP + col0 + bj * HALF); float zf[8]; unpack8(z, zf);
                    const f32x4 v0 = acc[ai][bj][m][0] * sv[bj][0], v1 = acc[ai][bj][m][1] * sv[bj][1];
                    u32x4 w; w.x = cvt_pk_bf16(v0[0] * zf[0], v0[1] * zf[1]); w.y = cvt_pk_bf16(v0[2] * zf[2], v0[3] * zf[3]); w.z = cvt_pk_bf16(v1[0] * zf[4], v1[1] * zf[5]); w.w = cvt_pk_bf16(v1[2] * zf[6], v1[3] * zf[7]);
                    *(u32x4*)(O + row * 2048 + 1024 + col0 + bj * HALF) = w; } }
    }
};
struct EpiGate {
    static constexpr bool PERM = true;
    bf16_t* O; const bf16_t* proj;
    __device__ __forceinline__ void operator()(f32x4 (&acc)[2][2][4][2], const Unit& u, int wr, int wc, int fr, int fq) const {
        const int row0 = u.pm * BM + wr * 64 + fr, col0 = u.pn * BM + wc * 32 + 8 * fq;
#pragma unroll
        for (int ai = 0; ai < 2; ++ai)
#pragma unroll
            for (int m = 0; m < 4; ++m) { const size_t row = (size_t)(row0 + ai * HALF + m * 16);
#pragma unroll
                for (int bj = 0; bj < 2; ++bj) { const u32x4 gp = *(const u32x4*)(proj + row * INC + C_G + 2048 + col0 + bj * HALF); float gpf[8]; unpack8(gp, gpf);
                    if (u.tag == 0) { const u32x4 ga = *(const u32x4*)(proj + row * INC + C_G + col0 + bj * HALF); float gaf[8]; unpack8(ga, gaf);
#pragma unroll
                        for (int e = 0; e < 4; ++e) { acc[ai][bj][m][0][e] *= gaf[e] * __builtin_amdgcn_rcpf(gpf[e]); acc[ai][bj][m][1][e] *= gaf[4 + e] * __builtin_amdgcn_rcpf(gpf[4 + e]); }
                    } else { const f32x4 v0 = acc[ai][bj][m][0], v1 = acc[ai][bj][m][1];
                        u32x4 w; w.x = cvt_pk_bf16(v0[0] * gpf[0], v0[1] * gpf[1]); w.y = cvt_pk_bf16(v0[2] * gpf[2], v0[3] * gpf[3]); w.z = cvt_pk_bf16(v1[0] * gpf[4], v1[1] * gpf[5]); w.w = cvt_pk_bf16(v1[2] * gpf[6], v1[3] * gpf[7]);
                        *(u32x4*)(O + row * 2048 + col0 + bj * HALF) = w; } } }
    }
};
struct EpiRes {
    static constexpr bool PERM = false;
    const float* x; float* out;
    __device__ __forceinline__ void operator()(f32x4 (&acc)[2][2][4][2], const Unit& u, int wr, int wc, int fr, int fq) const {
        const int row0 = u.pm * BM + wr * 64 + fr, col0 = u.pn * BM + wc * 32 + 4 * fq;
#pragma unroll
        for (int ai = 0; ai < 2; ++ai)
#pragma unroll
            for (int m = 0; m < 4; ++m) { const size_t off = (size_t)(row0 + ai * HALF + m * 16) * DM + col0;
#pragma unroll
                for (int bj = 0; bj < 2; ++bj)
#pragma unroll
                    for (int n = 0; n < 2; ++n) { const f32x4 bs = *(const f32x4*)(x + off + bj * HALF + n * 16); *(f32x4*)(out + off + bj * HALF + n * 16) = bs + acc[ai][bj][m][n]; } }
    }
};
}

constexpr int KROW = 288;
constexpr int ATT_K_OFF = 0, ATT_V_OFF = 256 * KROW;
constexpr int N_ATT_UNITS = 3 * BATCH * 8 * 32;

__device__ __forceinline__ void attn_unit(LAS unsigned char* lds, const bf16_t* __restrict__ proj, const float* __restrict__ ropec, const float* __restrict__ ropes,
                                          const float* __restrict__ qg, const float* __restrict__ kg, bf16_t* __restrict__ O, float* __restrict__ lse, int u) {
    const int tid = threadIdx.x, wid = __builtin_amdgcn_readfirstlane(tid >> 6), lane = tid & 63, fr = lane & 15, fq = lane >> 4;
    const int g = u >> 9, rem = u & 511, b = rem >> 8, h = (rem >> 5) & 7, sub = rem & 31;
    const int dsh = 2 * g, nbsh = 5 - dsh, r = sub >> nbsh, blk = sub & ((1 << nbsh) - 1);
    const size_t hcol = (size_t)g * 1024 + h * 128;
    {
        const int chunk = tid & 15, rowi = tid >> 4;
        float kgain[8];
#pragma unroll
        for (int e = 0; e < 8; ++e) kgain[e] = kg[chunk * 8 + e];
        u32x4 rawk[8], rawv[8];
#pragma unroll
        for (int p = 0; p < 8; ++p) {
            const int j = p * 32 + rowi, l = (blk - 1) * 128 + j; const bool valid = l >= 0;
            const int t = valid ? ((l << dsh) + r) : r;
            const bf16_t* rp = proj + (size_t)(b * SEQ + t) * INC + hcol + chunk * 8;
            rawk[p] = valid ? *(const u32x4*)(rp + C_K) : (u32x4){0u, 0u, 0u, 0u};
            rawv[p] = valid ? *(const u32x4*)(rp + C_V) : (u32x4){0u, 0u, 0u, 0u};
        }
#pragma unroll
        for (int p = 0; p < 8; ++p) {
            const int j = p * 32 + rowi, l = (blk - 1) * 128 + j; const int t = (l >= 0) ? ((l << dsh) + r) : r;
            float v[8]; unpack8(rawk[p], v);
            float ss = 0.f;
#pragma unroll
            for (int e = 0; e < 8; ++e) ss += v[e] * v[e];
            ss += __shfl_xor(ss, 1); ss += __shfl_xor(ss, 2); ss += __shfl_xor(ss, 4); ss += __shfl_xor(ss, 8);
            const float rs = rsqrtf(ss * (1.0f / 128.0f) + NORM_EPS);
#pragma unroll
            for (int e = 0; e < 8; ++e) v[e] = v[e] * rs * kgain[e];
            float ot[8];
#pragma unroll
            for (int e = 0; e < 8; ++e) ot[e] = __shfl_xor(v[e], 2);
            if (chunk < 4) {
                const float* cp = ropec + t * 16 + (chunk & 1) * 8; const float* sp = ropes + t * 16 + (chunk & 1) * 8;
                const f32x4 c0 = *(const f32x4*)cp, c1 = *(const f32x4*)(cp + 4), s0 = *(const f32x4*)sp, s1 = *(const f32x4*)(sp + 4);
                const float sg = (chunk < 2) ? -1.f : 1.f;
#pragma unroll
                for (int e = 0; e < 4; ++e) { v[e] = v[e] * c0[e] + sg * ot[e] * s0[e]; v[4 + e] = v[4 + e] * c1[e] + sg * ot[4 + e] * s1[e]; }
            }
            *(LAS u32x4*)(lds + ATT_K_OFF + j * KROW + chunk * 16) = pack8(v);
            *(LAS u32x4*)(lds + ATT_V_OFF + j * KROW + chunk * 16) = rawv[p];
        }
    }
    const int iq = 16 * wid + fr;
    const int tq = (((blk * 128) + iq) << dsh) + r;
    const size_t growq = (size_t)(b * SEQ + tq);
    bf16x8 qf[4];
    {
        u32x4 rawq[4];
#pragma unroll
        for (int ks = 0; ks < 4; ++ks) rawq[ks] = *(const u32x4*)(proj + growq * INC + C_Q + hcol + ks * 32 + fq * 8);
        float v[4][8]; float ss = 0.f;
#pragma unroll
        for (int ks = 0; ks < 4; ++ks) { unpack8(rawq[ks], v[ks]);
#pragma unroll
            for (int e = 0; e < 8; ++e) ss += v[ks][e] * v[ks][e]; }
        ss += __shfl_xor(ss, 16); ss += __shfl_xor(ss, 32);
        const float rs = rsqrtf(ss * (1.0f / 128.0f) + NORM_EPS);
#pragma unroll
        for (int ks = 0; ks < 4; ++ks)
#pragma unroll
            for (int e = 0; e < 8; ++e) v[ks][e] = v[ks][e] * rs * qg[ks * 32 + fq * 8 + e];
        {
            float ot[8];
#pragma unroll
            for (int e = 0; e < 8; ++e) ot[e] = __shfl_xor(v[0][e], 32);
            const float* cp = ropec + tq * 16 + (fq & 1) * 8; const float* sp = ropes + tq * 16 + (fq & 1) * 8;
            const f32x4 c0 = *(const f32x4*)cp, c1 = *(const f32x4*)(cp + 4), s0 = *(const f32x4*)sp, s1 = *(const f32x4*)(sp + 4);
            const float sg = (fq < 2) ? -1.f : 1.f;
#pragma unroll
            for (int e = 0; e < 4; ++e) { v[0][e] = v[0][e] * c0[e] + sg * ot[e] * s0[e]; v[0][4 + e] = v[0][4 + e] * c1[e] + sg * ot[4 + e] * s1[e]; }
        }
#pragma unroll
        for (int ks = 0; ks < 4; ++ks) qf[ks] = __builtin_bit_cast(bf16x8, pack8(v[ks]));
    }
    __syncthreads();
    const int kt0 = wid & ~1;
    f32x4 sacc[10];
#pragma unroll
    for (int t = 0; t < 10; ++t) { sacc[t] = (f32x4){0.f, 0.f, 0.f, 0.f};
#pragma unroll
        for (int ks = 0; ks < 4; ++ks) { const bf16x8 a = *(const LAS bf16x8*)(lds + ATT_K_OFF + ((kt0 + t) * 16 + fr) * KROW + (ks * 32 + fq * 8) * 2);
            sacc[t] = __builtin_amdgcn_mfma_f32_16x16x32_bf16(a, qf[ks], sacc[t], 0, 0, 0); } }
    const float scale = 0.08838834764831845f;
    float mx = -INFINITY;
#pragma unroll
    for (int t = 0; t < 10; ++t)
#pragma unroll
        for (int i = 0; i < 4; ++i) { const int j = (kt0 + t) * 16 + 4 * fq + i; const bool valid = (j >= iq) && (j <= iq + 128) && (blk > 0 || j >= 128);
            const float s = valid ? sacc[t][i] * scale : -INFINITY; sacc[t][i] = s; mx = fmaxf(mx, s); }
    mx = fmaxf(mx, __shfl_xor(mx, 16)); mx = fmaxf(mx, __shfl_xor(mx, 32));
    float sum = 0.f;
#pragma unroll
    for (int t = 0; t < 10; ++t)
#pragma unroll
        for (int i = 0; i < 4; ++i) { const float p = __builtin_amdgcn_exp2f((sacc[t][i] - mx) * 1.4426950408889634f); sacc[t][i] = p; sum += p; }
    sum += __shfl_xor(sum, 16); sum += __shfl_xor(sum, 32);
    bf16x8 pf[5];
#pragma unroll
    for (int s = 0; s < 5; ++s) { u32x4 w; w.x = cvt_pk_bf16(sacc[2 * s][0], sacc[2 * s][1]); w.y = cvt_pk_bf16(sacc[2 * s][2], sacc[2 * s][3]);
        w.z = cvt_pk_bf16(sacc[2 * s + 1][0], sacc[2 * s + 1][1]); w.w = cvt_pk_bf16(sacc[2 * s + 1][2], sacc[2 * s + 1][3]); pf[s] = __builtin_bit_cast(bf16x8, w); }
    f32x4 o[8];
#pragma unroll
    for (int dt = 0; dt < 8; ++dt) o[dt] = (f32x4){0.f, 0.f, 0.f, 0.f};
#pragma unroll
    for (int s = 0; s < 5; ++s) {
        const int key0 = kt0 * 16 + 32 * s + 4 * fq + (fr >> 2);
#pragma unroll
        for (int dt = 0; dt < 8; ++dt) {
            const LAS unsigned char* ap = lds + ATT_V_OFF + key0 * KROW + (dt * 16 + 4 * (fr & 3)) * 2;
            const v4i16_t lo = __builtin_amdgcn_ds_read_tr16_b64_v4i16((LAS v4i16_t*)ap);
            const v4i16_t hi = __builtin_amdgcn_ds_read_tr16_b64_v4i16((LAS v4i16_t*)(ap + 16 * KROW));
            const bf16x8 a = __builtin_shufflevector(lo, hi, 0, 1, 2, 3, 4, 5, 6, 7);
            o[dt] = __builtin_amdgcn_mfma_f32_16x16x32_bf16(a, pf[s], o[dt], 0, 0, 0);
        }
    }
    const float inv = 1.0f / sum;
    bf16_t* op = O + growq * 3072 + hcol + 4 * fq;
#pragma unroll
    for (int dt = 0; dt < 8; ++dt) { u32x2 w; w.x = cvt_pk_bf16(o[dt][0] * inv, o[dt][1] * inv); w.y = cvt_pk_bf16(o[dt][2] * inv, o[dt][3] * inv); *(u32x2*)(op + dt * 16) = w; }
    if (fq == 0) lse[growq * 24 + g * 8 + h] = mx + __logf(sum);
    __syncthreads();
}

__device__ __forceinline__ unsigned f2bf(float f) { unsigned u = __builtin_bit_cast(unsigned, f); return (u + 0x7fffu + ((u >> 16) & 1u)) >> 16; }
__device__ __forceinline__ unsigned pk2(float lo, float hi) { return f2bf(lo) | (f2bf(hi) << 16); }
__device__ __forceinline__ void transpose_item(const float* __restrict__ W, int ldw, bf16_t* __restrict__ WT, int ldt, LAS float* scr, int kb, int nb, int lane) {
    const int k0 = 64 * kb, n0 = 32 * nb;
#pragma unroll 8
    for (int i = 0; i < 32; ++i) { const int kk = 2 * i + (lane >> 5); scr[kk * 33 + (lane & 31)] = W[(size_t)(k0 + kk) * ldw + n0 + (lane & 31)]; }
    asm volatile("s_waitcnt lgkmcnt(0)" ::: "memory");
    const int c = lane & 7;
#pragma unroll
    for (int j = 0; j < 4; ++j) { const int n = (lane >> 3) + 8 * j; const LAS float* s = scr + (8 * c) * 33 + n;
        u32x4 o; o.x = pk2(s[0 * 33], s[1 * 33]); o.y = pk2(s[2 * 33], s[3 * 33]); o.z = pk2(s[4 * 33], s[5 * 33]); o.w = pk2(s[6 * 33], s[7 * 33]);
        *(u32x4*)(WT + (size_t)(n0 + n) * ldt + k0 + 8 * c) = o; }
    asm volatile("s_waitcnt lgkmcnt(0)" ::: "memory");
}

struct Args { const float* in[11]; float* out; unsigned char* ws; int ph_lo, ph_hi; };

__global__ void __launch_bounds__(NTHREADS, 2) fwd_kernel(Args args) {
    extern __shared__ __attribute__((aligned(16))) unsigned char lds_raw[];
    LAS unsigned char* lds = (LAS unsigned char*)lds_raw;
    const int tid = threadIdx.x, lane = tid & 63, wave = __builtin_amdgcn_readfirstlane(tid >> 6);
    const int G = gridDim.x, bx = blockIdx.x;
    const int lo = args.ph_lo, hi = args.ph_hi;
    unsigned char* ws = args.ws;
    const float* x = args.in[0]; const float* norm_gain = args.in[1]; const float* w_in = args.in[2]; const float* b_gates = args.in[3];
    const float* q_gain = args.in[4]; const float* k_gain = args.in[5]; const float* pool_maps = args.in[6]; const float* pool_scale = args.in[7];
    const float* w_ba = args.in[8]; const float* w_bp = args.in[9]; const float* w_out = args.in[10];
    bf16_t* WinT = (bf16_t*)(ws + WS_WIN); bf16_t* W12T = (bf16_t*)(ws + WS_W12); bf16_t* WoT = (bf16_t*)(ws + WS_WO); bf16_t* PMT = (bf16_t*)(ws + WS_PM);
    float* ropec = (float*)(ws + WS_ROPE); float* ropes = ropec + 4096 * 16;
    bf16_t* XN = (bf16_t*)(ws + WS_XN); bf16_t* PROJ = (bf16_t*)(ws + WS_PROJ); bf16_t* OB = (bf16_t*)(ws + WS_O); float* LSE = (float*)(ws + WS_LSE);
    bf16_t* DB = (bf16_t*)(ws + WS_D); bf16_t* A12 = (bf16_t*)(ws + WS_A12); bf16_t* MG = (bf16_t*)(ws + WS_MG);
#define IN(k) (lo <= (k) && (k) < hi)
#define SEAM(k) do { if (IN(k) && IN((k) + 1)) { cg::this_grid().sync(); } } while (0)

    if (IN(0)) {
        LAS float* scr = (LAS float*)(lds + wave * 16384);
        const int gw = bx * NWAVES + wave, NGW = G * NWAVES;
        constexpr int I_IN = 32 * 512, I_BA = 16 * 64, I_BP = 16 * 64, I_O = 32 * 64, I_PM = 4 * 32;
        constexpr int NITEMS = I_IN + I_BA + I_BP + I_O + I_PM;
        for (int it = gw; it < NITEMS; it += NGW) {
            int r = it;
            if (r < I_IN) { transpose_item(w_in, INC, WinT, 2048, scr, r / 512, r % 512, lane); continue; } r -= I_IN;
            if (r < I_BA) { transpose_item(w_ba, 2048, W12T, 2048, scr, r / 64, r % 64, lane); continue; } r -= I_BA;
            if (r < I_BP) { transpose_item(w_bp, 2048, W12T + 1024, 2048, scr, r / 64, r % 64, lane); continue; } r -= I_BP;
            if (r < I_O) { transpose_item(w_out, 2048, WoT, 2048, scr, r / 64, r % 64, lane); continue; } r -= I_O;
            { const int gi = r >> 5, rr = r & 31; transpose_item(pool_maps + (size_t)gi * 65536, 256, PMT + (size_t)gi * 65536, 256, scr, rr >> 3, rr & 7, lane); }
        }
        for (int m = gw; m < M; m += NGW) {
            const f32x4* xr = (const f32x4*)(x + (size_t)m * DM) + lane;
            f32x4 v[8]; float s = 0.f;
#pragma unroll
            for (int j = 0; j < 8; ++j) { v[j] = xr[64 * j]; s += (v[j].x * v[j].x + v[j].y * v[j].y) + (v[j].z * v[j].z + v[j].w * v[j].w); }
#pragma unroll
            for (int o = 1; o < 64; o <<= 1) s += __shfl_xor(s, o);
            const float rs = rsqrtf(s * (1.0f / DM) + NORM_EPS);
            u32x2* o8 = (u32x2*)(XN + (size_t)m * DM) + lane;
#pragma unroll
            for (int j = 0; j < 8; ++j) { const f32x4 gn = *((const f32x4*)norm_gain + lane + 64 * j); u32x2 w; w.x = cvt_pk_bf16(v[j].x * rs * gn.x, v[j].y * rs * gn.y); w.y = cvt_pk_bf16(v[j].z * rs * gn.z, v[j].w * rs * gn.w); o8[64 * j] = w; }
        }
        {
            const float invf[16] = {1.000000000e+00f, 4.403665960e-01f, 1.939227432e-01f, 8.539710194e-02f, 3.760603070e-02f, 1.656043902e-02f, 7.292664610e-03f, 3.211445874e-03f,
                                    1.414213562e-03f, 6.227723788e-04f, 2.742481884e-04f, 1.207697351e-04f, 5.318296098e-05f, 2.341999971e-05f, 1.031338616e-05f, 4.541670478e-06f};
            for (int idx = bx * NTHREADS + tid; idx < 4096 * 16; idx += G * NTHREADS) {
                const int pos = idx >> 4, j = idx & 15;
                float f = invf[0];
#pragma unroll
                for (int q = 1; q < 16; ++q) f = (j == q) ? invf[q] : f;
                const float ang = (float)pos * f;
                double rev = (double)ang * 0.15915494309189535; rev -= __builtin_rint(rev);
                const float rf = (float)rev;
                ropec[idx] = __builtin_amdgcn_cosf(rf); ropes[idx] = __builtin_amdgcn_sinf(rf);
            }
        }
        __syncthreads();
    }
    SEAM(0);

    if (IN(1)) {
        pg8::Gemm g{XN, WinT, 2048, 2048, 2048}; pg8::SchedStd S{M / 256, INC / 256, G, bx};
        pg8::EpiProj E{PROJ, b_gates};
        pg8::gemm_phase<pg8::EpiProj, pg8::SchedStd, true>(lds, g, S, E);
    }
    SEAM(1);

    if (IN(2)) {
        const int per = (N_ATT_UNITS + G - 1) / G;
        for (int i = 0; i < per; ++i) { const int u = bx * per + i; if (u < N_ATT_UNITS) attn_unit(lds, PROJ, ropec, ropes, q_gain, k_gain, OB, LSE, u); }
        for (int it = bx * NTHREADS + tid; it < M * 128; it += G * NTHREADS) {
            const int row = it >> 7, ch = it & 127, s = row & (SEQ - 1), ksz = 2 << (ch >> 5);
            const int cnt = (s + 1 < ksz) ? (s + 1) : ksz;
            const bf16_t* up = PROJ + (size_t)row * INC + C_U + ch * 8;
            float acc[8], cur[8];
            unpack8(*(const u32x4*)up, cur);
#pragma unroll
            for (int e = 0; e < 8; ++e) acc[e] = cur[e];
            for (int d = 1; d < cnt; ++d) { float t[8]; unpack8(*(const u32x4*)(up - (size_t)d * INC), t);
#pragma unroll
                for (int e = 0; e < 8; ++e) acc[e] += t[e]; }
            const float ic = 1.0f / (float)cnt;
#pragma unroll
            for (int e = 0; e < 8; ++e) acc[e] = acc[e] * ic - cur[e];
            *(u32x4*)(DB + (size_t)row * 1024 + ch * 8) = pack8(acc);
        }
    }
    SEAM(2);

    if (IN(3)) {
        for (int it = bx * NTHREADS + tid; it < M * 128; it += G * NTHREADS) {
            const int row = it >> 7, ch = it & 127, h = ch >> 4;
            const float l0 = LSE[(size_t)row * 24 + h], l1 = LSE[(size_t)row * 24 + 8 + h], l2 = LSE[(size_t)row * 24 + 16 + h];
            const float mxl = fmaxf(l0, fmaxf(l1, l2));
            float w0 = __expf(l0 - mxl), w1 = __expf(l1 - mxl), w2 = __expf(l2 - mxl); const float iw = 1.0f / (w0 + w1 + w2); w0 *= iw; w1 *= iw; w2 *= iw;
            const bf16_t* op = OB + (size_t)row * 3072 + ch * 8;
            float a0[8], a1[8], a2[8], z[8], r[8];
            unpack8(*(const u32x4*)op, a0); unpack8(*(const u32x4*)(op + 1024), a1); unpack8(*(const u32x4*)(op + 2048), a2);
            unpack8(*(const u32x4*)(PROJ + (size_t)row * INC + C_ZA + ch * 8), z);
#pragma unroll
            for (int e = 0; e < 8; ++e) r[e] = (w0 * a0[e] + w1 * a1[e] + w2 * a2[e]) * z[e];
            *(u32x4*)(A12 + (size_t)row * 2048 + ch * 8) = pack8(r);
        }
        __syncthreads();
        pg8::Gemm g{DB, PMT, 1024, 256, 256}; pg8::SchedPool S{G, bx};
        pg8::EpiPool E{A12, PROJ, pool_scale};
        pg8::gemm_phase<pg8::EpiPool, pg8::SchedPool, false>(lds, g, S, E);
    }
    SEAM(3);

    if (IN(4)) {
        pg8::Gemm g{A12, W12T, 2048, 2048, 1024}; pg8::SchedDual S{M / 256, DM / 256, G, bx};
        pg8::EpiGate E{MG, PROJ};
        pg8::gemm_phase<pg8::EpiGate, pg8::SchedDual, true>(lds, g, S, E);
    }
    SEAM(4);

    if (IN(5)) {
        pg8::Gemm g{MG, WoT, 2048, 2048, 2048}; pg8::SchedStd S{M / 256, DM / 256, G, bx};
        pg8::EpiRes E{x, args.out};
        pg8::gemm_phase<pg8::EpiRes, pg8::SchedStd, false>(lds, g, S, E);
    }
#undef IN
#undef SEAM
}

extern "C" void kernel_launch(void* const* d_in, const int* in_sizes, int n_in, void* d_out, int out_size, void* d_ws, size_t ws_size, hipStream_t stream) {
    static int grid = 0;
    if (grid == 0) {
        if (n_in != 11 || ws_size < WS_END) { fprintf(stderr, "kernel_launch: unexpected problem (n_in %d, ws %zu)\n", n_in, ws_size); grid = -1; return; }
        int dev = 0, cus = 0, per_cu = 0;
        hipGetDevice(&dev); hipDeviceGetAttribute(&cus, hipDeviceAttributeMultiprocessorCount, dev);
        if (hipFuncSetAttribute((const void*)fwd_kernel, hipFuncAttributeMaxDynamicSharedMemorySize, LDS_BYTES) != hipSuccess) { fprintf(stderr, "kernel_launch: hipFuncSetAttribute failed\n"); grid = -1; return; }
        if (hipOccupancyMaxActiveBlocksPerMultiprocessor(&per_cu, (const void*)fwd_kernel, NTHREADS, LDS_BYTES) != hipSuccess || per_cu < 1) { fprintf(stderr, "kernel_launch: occupancy query says %d\n", per_cu); per_cu = 1; }
        (void)hipGetLastError();
        grid = cus;
        fprintf(stderr, "kernel_launch: grid %d (per_cu %d)\n", grid, per_cu);
    }
    if (grid < 0) return;
    Args a{};
    for (int i = 0; i < 11; ++i) a.in[i] = (const float*)d_in[i];
    a.out = (float*)d_out; a.ws = (unsigned char*)d_ws;
#if MK_N_LAUNCHES == 1
    a.ph_lo = 0; a.ph_hi = 6;
    void* kargs[] = {&a};
    hipError_t e = hipLaunchCooperativeKernel((const void*)fwd_kernel, dim3(grid), dim3(NTHREADS), kargs, LDS_BYTES, stream);
    if (e != hipSuccess) fprintf(stderr, "cooperative launch failed: %s (grid %d)\n", hipGetErrorString(e), grid);
#else
    for (int p = 0; p < 6; ++p) { a.ph_lo = p; a.ph_hi = p + 1; hipLaunchKernelGGL(fwd_kernel, dim3(grid), dim3(NTHREADS), LDS_BYTES, stream, a); }
#endif
}
```

```cpp
#include <hip/hip_runtime.h>
#include <hip/hip_cooperative_groups.h>
#include <cstdio>
#include <cstdint>
namespace cg = cooperative_groups;

#ifndef MK_N_LAUNCHES
#define MK_N_LAUNCHES 1
#endif

#ifndef PROBE_PHASE
#define PROBE_PHASE -1
#endif
#ifndef PROBE_REPS
#define PROBE_REPS 1
#endif
#ifndef PROBE_FLAGS
#define PROBE_FLAGS 0
#endif

#define LAS __attribute__((address_space(3)))
typedef unsigned short bf16_t;
typedef short bf16x8 __attribute__((ext_vector_type(8)));
typedef short v4i16_t __attribute__((ext_vector_type(4)));
typedef float f32x4 __attribute__((ext_vector_type(4)));
typedef unsigned u32x4 __attribute__((ext_vector_type(4)));
typedef unsigned u32x2 __attribute__((ext_vector_type(2)));

constexpr int BATCH = 2, SEQ = 4096, DM = 2048, M = BATCH * SEQ, INC = 16384, HD = 128;
constexpr int LDP = 2048;
constexpr int C_ZA = 0, C_U = 1024;
__host__ __device__ __forceinline__ size_t frag_off(int tile, int k, int wave, int lane) { return ((((size_t)tile * 16 + k) * 8 + wave) * 64 + lane) * 8; }
__host__ __device__ __forceinline__ size_t qkv_off(int row, int chunk  ) { return (size_t)(row >> 4) * 2048 + (size_t)(chunk >> 2) * 512 + (size_t)(row & 15) * 32 + (size_t)(chunk & 3) * 8; }
constexpr size_t HSZ = (size_t)SEQ * HD;

constexpr float NORM_EPS = 1e-6f;
constexpr int NTHREADS = 512, NWAVES = 8;

constexpr size_t MiB = 1u << 20;
constexpr size_t WS_CTL = 0;
constexpr size_t WS_WIN = 2 * MiB;
constexpr size_t WS_W12 = 66 * MiB;
constexpr size_t WS_WO = 74 * MiB;
constexpr size_t WS_PM = 82 * MiB;
constexpr size_t WS_ROPE = 83 * MiB;
constexpr size_t WS_XN = 84 * MiB;
constexpr size_t WS_PROJ = 116 * MiB;
constexpr size_t WS_ZPF = 148 * MiB;
constexpr size_t WS_GF = 164 * MiB;
constexpr size_t WS_QKV = 228 * MiB;
constexpr size_t WS_O = 372 * MiB;
constexpr size_t WS_LSE = 420 * MiB;
constexpr size_t WS_D = 422 * MiB;
constexpr size_t WS_A12 = 438 * MiB;
constexpr size_t WS_MG = 470 * MiB;
constexpr size_t WS_END = 502 * MiB;

constexpr int LDS_BYTES = 152 * 1024;

__device__ __forceinline__ unsigned cvt_pk_bf16(float lo, float hi) { unsigned r; asm volatile("v_cvt_pk_bf16_f32 %0, %1, %2" : "=v"(r) : "v"(lo), "v"(hi)); return r; }
__device__ __forceinline__ float bf_lo(unsigned w) { return __uint_as_float(w << 16); }
__device__ __forceinline__ float bf_hi(unsigned w) { return __uint_as_float(w & 0xffff0000u); }
__device__ __forceinline__ float fast_sigmoid(float v) { return __builtin_amdgcn_rcpf(1.0f + __builtin_amdgcn_exp2f(-1.4426950408889634f * v)); }
__device__ __forceinline__ void unpack8(const u32x4 w, float (&v)[8]) {
    v[0] = bf_lo(w.x); v[1] = bf_hi(w.x); v[2] = bf_lo(w.y); v[3] = bf_hi(w.y); v[4] = bf_lo(w.z); v[5] = bf_hi(w.z); v[6] = bf_lo(w.w); v[7] = bf_hi(w.w);
}
__device__ __forceinline__ u32x4 pack8(const float (&v)[8]) {
    u32x4 w; w.x = cvt_pk_bf16(v[0], v[1]); w.y = cvt_pk_bf16(v[2], v[3]); w.z = cvt_pk_bf16(v[4], v[5]); w.w = cvt_pk_bf16(v[6], v[7]); return w;
}

namespace pg8 {
constexpr int BM = 256, BK = 64, HALF = 128, HTB = HALF * BK * 2, STAGE_BYTES = 8 * HTB, NXCD = 8, WGM = 8;
__host__ __device__ __forceinline__ int lds_byte(int r, int c) { const int st = (r >> 4) * 2 + (c >> 5), rr = r & 15, cc = c & 31, ob = rr * 64 + cc * 2; return st * 1024 + (ob ^ (((ob >> 9) & 1) << 5)); }
__host__ __device__ __forceinline__ void stage_rc(int b, int& R, int& C) { const int st = b / 1024, sb = b % 1024, swz = sb ^ (((sb >> 9) & 1) << 5); R = (st >> 1) * 16 + swz / 64; C = (st & 1) * 32 + (swz % 64) / 2; }
__host__ __device__ __forceinline__ int perm32(int rho) { const int n = rho >> 4, i = rho & 15; return 8 * (i >> 2) + 4 * n + (i & 3); }

struct Unit { int pm, pn, acol, bcol, tag, keep; };
struct Gemm { const bf16_t* A; const bf16_t* Bt; int lda, ldb, K; };

__device__ __forceinline__ void tile_of(int L, int nM, int nN, int& pm, int& pn) {
    const int nwg = nM * nN; int wgid = L;
    { const int q = nwg / NXCD, r = nwg % NXCD, xcd = wgid % NXCD, off = wgid / NXCD; wgid = (xcd < r ? xcd * (q + 1) : r * (q + 1) + (xcd - r) * q) + off; }
    const int nig = WGM * nN, gid = wgid / nig, fm = gid * WGM, gsz = (nM - fm) < WGM ? (nM - fm) : WGM;
    pm = fm + ((wgid % nig) % gsz); pn = (wgid % nig) / gsz;
}
struct SchedStd {
    int nM, nN, G, c;
    __device__ __forceinline__ bool next(int i, Unit& u) const { const long L = (long)i * G + c; if (L >= (long)nM * nN) return false; tile_of((int)L, nM, nN, u.pm, u.pn); u.acol = 0; u.bcol = 0; u.tag = 0; u.keep = 0; return true; }
};
struct SchedPool {
    int G, c;
    __device__ __forceinline__ bool next(int i, Unit& u) const { const int L = i * G + c; if (L >= 128) return false; u.pm = L >> 2; u.pn = L & 3; u.acol = u.pn * 256; u.bcol = 0; u.tag = 0; u.keep = 0; return true; }
};
struct SchedDual {
    int nM, nN, G, c;
    __device__ __forceinline__ bool next(int i, Unit& u) const { const long L = (long)(i >> 1) * G + c; if (L >= (long)nM * nN) return false; tile_of((int)L, nM, nN, u.pm, u.pn); u.tag = i & 1; u.acol = u.bcol = u.tag * 1024; u.keep = (u.tag == 0); return true; }
};

template <class Epi, class Sched, bool ALIGN_EPI>
__device__ __forceinline__ void gemm_phase(LAS unsigned char* lds, const Gemm g, const Sched& S, const Epi& E) {
    const int tid = threadIdx.x, wid = __builtin_amdgcn_readfirstlane(tid >> 6), lane = tid & 63, wr = wid >> 2, wc = wid & 3, fr = lane & 15, fq = lane >> 4;
    const int nt = g.K / BK;
    unsigned voffA[2], voffB[2];
#pragma unroll
    for (int i = 0; i < 2; ++i) { int R, C; stage_rc(tid * 16 + i * 8192, R, C); const int Rb = Epi::PERM ? ((R & ~31) + perm32(R & 31)) : R;
        voffA[i] = (unsigned)(R * g.lda + C) * 2u; voffB[i] = (unsigned)(Rb * g.ldb + C) * 2u; }
    const size_t kstep = (size_t)(BK * 2);
    const size_t hsA = (size_t)HALF * g.lda * 2, hsB = (size_t)HALF * g.ldb * 2;
    const unsigned ldsw = (unsigned)wid * 1024u;
    const int aoff = lds_byte(wr * 64 + fr, fq * 8), boff = lds_byte(wc * 32 + fr, fq * 8);
#define PG8_SA(b, h) (((b) * 2 + (h)) * HTB)
#define PG8_SB(b, h) ((4 + (b) * 2 + (h)) * HTB)
#define PG8_STAGE(bufoff, gbase, voff) do { _Pragma("unroll") for (int _i = 0; _i < 2; ++_i) \
        __builtin_amdgcn_global_load_lds((const unsigned*)((const char*)(gbase) + (voff)[_i]), (LAS unsigned*)(lds + (bufoff) + ldsw + _i * 8192), 16, 0, 0); } while (0)
#define PG8_LDA(dst, b, h) do { _Pragma("unroll") for (int m = 0; m < 4; ++m) _Pragma("unroll") for (int k = 0; k < 2; ++k) dst[m][k] = *(const LAS bf16x8*)(lds + PG8_SA(b, h) + aoff + m * 2048 + k * 1024); } while (0)
#define PG8_LDB(dst, b, h) do { _Pragma("unroll") for (int n = 0; n < 2; ++n) _Pragma("unroll") for (int k = 0; k < 2; ++k) dst[n][k] = *(const LAS bf16x8*)(lds + PG8_SB(b, h) + boff + n * 2048 + k * 1024); } while (0)
#define PG8_MMA(ai, bj, At, Bt) do { __builtin_amdgcn_s_setprio(1); _Pragma("unroll") for (int m = 0; m < 4; ++m) _Pragma("unroll") for (int n = 0; n < 2; ++n) _Pragma("unroll") for (int k = 0; k < 2; ++k) \
        acc[ai][bj][m][n] = __builtin_amdgcn_mfma_f32_16x16x32_bf16(Bt[n][k], At[m][k], acc[ai][bj][m][n], 0, 0, 0); __builtin_amdgcn_s_setprio(0); } while (0)
#define PG8_WAIT_V(n) asm volatile("s_waitcnt vmcnt(" #n ")" ::: "memory")
#define PG8_WAIT_L(n) asm volatile("s_waitcnt lgkmcnt(" #n ")" ::: "memory")
#define PG8_BAR __builtin_amdgcn_s_barrier()
#define PG8_SCHED __builtin_amdgcn_sched_barrier(0)
    Unit cur, nxt; int ui = 0;
    if (!S.next(0, cur)) return;
    f32x4 acc[2][2][4][2];
#pragma unroll
    for (int a = 0; a < 2; ++a)
#pragma unroll
        for (int b = 0; b < 2; ++b)
#pragma unroll
            for (int m = 0; m < 4; ++m)
#pragma unroll
                for (int n = 0; n < 2; ++n) acc[a][b][m][n] = (f32x4){0.f, 0.f, 0.f, 0.f};
    if constexpr (Epi::PRELOAD) E.init(acc, cur, wr, wc, fr, fq);
    bf16x8 At[4][2], B0[2][2], B1[2][2];
    const char* cA = (const char*)g.A + ((size_t)cur.pm * BM * g.lda + cur.acol) * 2; const char* cB = (const char*)g.Bt + ((size_t)cur.pn * BM * g.ldb + cur.bcol) * 2;
    PG8_STAGE(PG8_SB(0, 0), cB, voffB); PG8_STAGE(PG8_SB(0, 1), cB + hsB, voffB); PG8_STAGE(PG8_SA(0, 0), cA, voffA); PG8_STAGE(PG8_SA(0, 1), cA + hsA, voffA);
    if (wr == 1) PG8_BAR;
    PG8_WAIT_V(2); PG8_BAR;
    PG8_STAGE(PG8_SB(1, 0), cB + kstep, voffB); PG8_STAGE(PG8_SA(1, 0), cA + kstep, voffA); PG8_STAGE(PG8_SB(1, 1), cB + hsB + kstep, voffB);
    PG8_WAIT_V(6); PG8_BAR;
    for (;;) {
        const bool has_next = S.next(ui + 1, nxt);
        const char* nA = has_next ? (const char*)g.A + ((size_t)nxt.pm * BM * g.lda + nxt.acol) * 2 : cA; const char* nB = has_next ? (const char*)g.Bt + ((size_t)nxt.pn * BM * g.ldb + nxt.bcol) * 2 : cB;
#pragma nounroll
        for (int t = 0; t < nt; t += 2) {
            const bool last = (t == nt - 2);
            const char* a1 = cA + (size_t)(t + 1) * kstep;
            const char* a2 = last ? nA : cA + (size_t)(t + 2) * kstep; const char* b2 = last ? nB : cB + (size_t)(t + 2) * kstep;
            const char* a3 = a2 + kstep; const char* b3 = b2 + kstep;
            PG8_LDB(B0, 0, 0); PG8_LDB(B1, 0, 1); PG8_SCHED; PG8_LDA(At, 0, 0); PG8_STAGE(PG8_SA(1, 1), a1 + hsA, voffA);
            PG8_WAIT_V(8); PG8_WAIT_L(0); PG8_BAR; PG8_MMA(0, 0, At, B0); PG8_MMA(0, 1, At, B1); PG8_BAR; PG8_SCHED;
            PG8_LDA(At, 0, 1); PG8_STAGE(PG8_SB(0, 0), b2, voffB); PG8_STAGE(PG8_SB(0, 1), b2 + hsB, voffB); PG8_STAGE(PG8_SA(0, 0), a2, voffA);
            PG8_WAIT_V(8); PG8_WAIT_L(0); PG8_BAR; PG8_MMA(1, 0, At, B0); PG8_MMA(1, 1, At, B1); PG8_BAR; PG8_SCHED;
            PG8_LDB(B0, 1, 0); PG8_LDB(B1, 1, 1); PG8_SCHED; PG8_LDA(At, 1, 0); PG8_STAGE(PG8_SA(0, 1), a2 + hsA, voffA);
            PG8_WAIT_V(8); PG8_WAIT_L(0); PG8_BAR; PG8_MMA(0, 0, At, B0); PG8_MMA(0, 1, At, B1); PG8_BAR; PG8_SCHED;
            PG8_LDA(At, 1, 1); PG8_STAGE(PG8_SB(1, 0), b3, voffB); PG8_STAGE(PG8_SB(1, 1), b3 + hsB, voffB); PG8_STAGE(PG8_SA(1, 0), a3, voffA);
            PG8_WAIT_V(8); PG8_WAIT_L(0); PG8_BAR; PG8_MMA(1, 0, At, B0); PG8_MMA(1, 1, At, B1); PG8_BAR; PG8_SCHED;
        }
        if constexpr (ALIGN_EPI) { if (wr == 0) PG8_BAR; }
        if constexpr (!Epi::AFTER_DRAIN) E(acc, cur, wr, wc, fr, fq);
        if (!has_next) break;
        if (!cur.keep) {
#pragma unroll
            for (int a = 0; a < 2; ++a)
#pragma unroll
                for (int b = 0; b < 2; ++b)
#pragma unroll
                    for (int m = 0; m < 4; ++m)
#pragma unroll
                        for (int n = 0; n < 2; ++n) acc[a][b][m][n] = (f32x4){0.f, 0.f, 0.f, 0.f};
            if constexpr (Epi::PRELOAD) E.init(acc, nxt, wr, wc, fr, fq);
        }
        cur = nxt; cA = nA; cB = nB; ++ui;
        if constexpr (ALIGN_EPI) { if (wr == 1) PG8_BAR; }
    }
    PG8_WAIT_V(0);
    if constexpr (!ALIGN_EPI) { if (wr == 0) PG8_BAR; }
    PG8_BAR;
    if constexpr (Epi::AFTER_DRAIN) E.after(acc, cur, wr, wc, fr, fq, lds, wid, lane);
#undef PG8_SA
#undef PG8_SB
#undef PG8_STAGE
#undef PG8_LDA
#undef PG8_LDB
#undef PG8_MMA
#undef PG8_WAIT_V
#undef PG8_WAIT_L
#undef PG8_BAR
#undef PG8_SCHED
}

struct EpiProj {
    static constexpr bool AFTER_DRAIN = false;
    static constexpr bool PRELOAD = false;
    static constexpr bool PERM = true;
    bf16_t* O; bf16_t* QKV; const float* bg; bf16_t* ZPF; bf16_t* GF;
    __device__ __forceinline__ void operator()(f32x4 (&acc)[2][2][4][2], const Unit& u, int wr, int wc, int fr, int fq) const {
        const int row0 = u.pm * BM + wr * 64 + fr;
        if (u.pn < 36) {
            const int w = u.pn / 12, pr = u.pn - w * 12, g = pr >> 2, dsh = 2 * g;
#pragma unroll
            for (int ai = 0; ai < 2; ++ai)
#pragma unroll
                for (int m = 0; m < 4; ++m) { const int row = row0 + ai * HALF + m * 16, b = row >> 12, t = row & (SEQ - 1);
                    const int ridx = ((t & ((1 << dsh) - 1)) << (12 - dsh)) + (t >> dsh);
#pragma unroll
                    for (int bj = 0; bj < 2; ++bj) { const int h = (pr & 3) * 2 + bj;
                        bf16_t* dst = QKV + ((size_t)((w * 2 + b) * 3 + g) * 8 + h) * HSZ + qkv_off(ridx, wc * 4 + fq);
                        const f32x4 v0 = acc[ai][bj][m][0], v1 = acc[ai][bj][m][1];
                        u32x4 wv; wv.x = cvt_pk_bf16(v0[0], v0[1]); wv.y = cvt_pk_bf16(v0[2], v0[3]); wv.z = cvt_pk_bf16(v1[0], v1[1]); wv.w = cvt_pk_bf16(v1[2], v1[3]);
                        *(u32x4*)dst = wv; } }
            return;
        }
        const int col0 = (u.pn - 36) * BM + wc * 32 + 8 * fq;
        const int mode = (u.pn >= 48) ? 2 : (((u.pn >= 36 && u.pn < 40) || (u.pn >= 44)) ? 1 : 0);
        bf16_t* fbase = (u.pn >= 48) ? GF + frag_off(u.pm * 16 + (u.pn - 48), 0, 0, 0) : ZPF + frag_off(u.pm * 4 + (u.pn - 44), 0, 0, 0);
        const int bjs = (u.pn >= 44) ? 4096 : HALF;
        f32x4 bv[2][2];
#pragma unroll
        for (int bj = 0; bj < 2; ++bj)
#pragma unroll
            for (int n = 0; n < 2; ++n) bv[bj][n] = (mode == 2) ? *(const f32x4*)(bg + (u.pn - 48) * BM + wc * 32 + 8 * fq + bj * HALF + 4 * n) : (f32x4){0.f, 0.f, 0.f, 0.f};
#pragma unroll
        for (int ai = 0; ai < 2; ++ai)
#pragma unroll
            for (int m = 0; m < 4; ++m) { bf16_t* rowp;
                if (u.pn >= 44) rowp = fbase + frag_off(0, ai * 8 + m * 2, wr * 4 + wc, fq * 16 + fr); else rowp = O + (size_t)(row0 + ai * HALF + m * 16) * LDP + col0;
#pragma unroll
                for (int bj = 0; bj < 2; ++bj) { f32x4 v0 = acc[ai][bj][m][0] + bv[bj][0], v1 = acc[ai][bj][m][1] + bv[bj][1];
                    if (mode == 1) {
#pragma unroll
                        for (int e = 0; e < 4; ++e) { v0[e] = v0[e] * fast_sigmoid(v0[e]); v1[e] = v1[e] * fast_sigmoid(v1[e]); }
                    } else if (mode == 2) {
#pragma unroll
                        for (int e = 0; e < 4; ++e) { v0[e] = fast_sigmoid(v0[e]); v1[e] = fast_sigmoid(v1[e]); }
                    }
                    u32x4 w; w.x = cvt_pk_bf16(v0[0], v0[1]); w.y = cvt_pk_bf16(v0[2], v0[3]); w.z = cvt_pk_bf16(v1[0], v1[1]); w.w = cvt_pk_bf16(v1[2], v1[3]);
                    *(u32x4*)(rowp + bj * bjs) = w; } }
    }
};
struct EpiPool {
    static constexpr bool AFTER_DRAIN = false;
    static constexpr bool PRELOAD = false;
    static constexpr bool PERM = true;
    bf16_t* O; const bf16_t* proj; const float* ps;
    __device__ __forceinline__ void operator()(f32x4 (&acc)[2][2][4][2], const Unit& u, int wr, int wc, int fr, int fq) const {
        const int row0 = u.pm * BM + wr * 64 + fr, col0 = u.pn * BM + wc * 32 + 8 * fq;
        f32x4 sv[2][2];
#pragma unroll
        for (int bj = 0; bj < 2; ++bj)
#pragma unroll
            for (int n = 0; n < 2; ++n) sv[bj][n] = *(const f32x4*)(ps + col0 + bj * HALF + 4 * n);
#pragma unroll
        for (int ai = 0; ai < 2; ++ai)
#pragma unroll
            for (int m = 0; m < 4; ++m) { const size_t row = (size_t)(row0 + ai * HALF + m * 16);
#pragma unroll
                for (int bj = 0; bj < 2; ++bj) { const u32x4 z = *(const u32x4*)(proj + frag_off(u.pm * 4 + u.pn, ai * 8 + m * 2 + bj, wr * 4 + wc, fq * 16 + fr)); float zf[8]; unpack8(z, zf);
                    const f32x4 v0 = acc[ai][bj][m][0] * sv[bj][0], v1 = acc[ai][bj][m][1] * sv[bj][1];
                    u32x4 w; w.x = cvt_pk_bf16(v0[0] * zf[0], v0[1] * zf[1]); w.y = cvt_pk_bf16(v0[2] * zf[2], v0[3] * zf[3]); w.z = cvt_pk_bf16(v1[0] * zf[4], v1[1] * zf[5]); w.w = cvt_pk_bf16(v1[2] * zf[6], v1[3] * zf[7]);
                    *(u32x4*)(O + row * 2048 + 1024 + col0 + bj * HALF) = w; } }
    }
};
struct EpiGate {
    static constexpr bool AFTER_DRAIN = false;
    static constexpr bool PRELOAD = false;
    static constexpr bool PERM = true;
    bf16_t* O; const bf16_t* proj;
    __device__ __forceinline__ void operator()(f32x4 (&acc)[2][2][4][2], const Unit& u, int wr, int wc, int fr, int fq) const {
        asm volatile("" : "+v"(fr), "+v"(fq));
        const int row0 = u.pm * BM + wr * 64 + fr, col0 = u.pn * BM + wc * 32 + 8 * fq;
#pragma unroll
        for (int ai = 0; ai < 2; ++ai)
#pragma unroll
            for (int m = 0; m < 4; ++m) { const size_t row = (size_t)(row0 + ai * HALF + m * 16);
#pragma unroll
                for (int bj = 0; bj < 2; ++bj) { const u32x4 gp = *(const u32x4*)(proj + frag_off(u.pm * 16 + 8 + u.pn, ai * 8 + m * 2 + bj, wr * 4 + wc, fq * 16 + fr)); float gpf[8]; unpack8(gp, gpf);
#pragma unroll
                    for (int e = 0; e < 8; ++e) gpf[e] = fmaxf(gpf[e], 1e-4f);
                    if (u.tag == 0) { const u32x4 ga = *(const u32x4*)(proj + frag_off(u.pm * 16 + u.pn, ai * 8 + m * 2 + bj, wr * 4 + wc, fq * 16 + fr)); float gaf[8]; unpack8(ga, gaf);
#pragma unroll
                        for (int e = 0; e < 4; ++e) { acc[ai][bj][m][0][e] *= gaf[e] * __builtin_amdgcn_rcpf(gpf[e]); acc[ai][bj][m][1][e] *= gaf[4 + e] * __builtin_amdgcn_rcpf(gpf[4 + e]); }
                    } else { const f32x4 v0 = acc[ai][bj][m][0], v1 = acc[ai][bj][m][1];
                        u32x4 w; w.x = cvt_pk_bf16(v0[0] * gpf[0], v0[1] * gpf[1]); w.y = cvt_pk_bf16(v0[2] * gpf[2], v0[3] * gpf[3]); w.z = cvt_pk_bf16(v1[0] * gpf[4], v1[1] * gpf[5]); w.w = cvt_pk_bf16(v1[2] * gpf[6], v1[3] * gpf[7]);
                        *(u32x4*)(O + row * 2048 + col0 + bj * HALF) = w; } } }
    }
};
struct EpiRes {
    static constexpr bool PERM = false, PRELOAD = true;
    const float* x; float* out;
    __device__ __forceinline__ void init(f32x4 (&acc)[2][2][4][2], const Unit& u, int wr, int wc, int fr, int fq) const {
        const int row0 = u.pm * BM + wr * 64 + fr, col0 = u.pn * BM + wc * 32 + 4 * fq;
#pragma unroll
        for (int ai = 0; ai < 2; ++ai)
#pragma unroll
            for (int m = 0; m < 4; ++m) { const size_t off = (size_t)(row0 + ai * HALF + m * 16) * DM + col0;
#pragma unroll
                for (int bj = 0; bj < 2; ++bj)
#pragma unroll
                    for (int n = 0; n < 2; ++n) acc[ai][bj][m][n] = __builtin_nontemporal_load((const f32x4*)(x + off + bj * HALF + n * 16)); }
    }
    static constexpr bool AFTER_DRAIN = true;
    __device__ __forceinline__ void after(f32x4 (&acc)[2][2][4][2], const Unit& u, int wr, int wc, int fr, int fq, LAS unsigned char* lds, int wid, int lane) const {
        constexpr int RP = 1040;
        asm volatile("" : "+v"(lane), "+v"(fr));
#pragma unroll
        for (int ai = 0; ai < 2; ++ai) {
#pragma unroll
            for (int m = 0; m < 4; ++m)
#pragma unroll
                for (int bj = 0; bj < 2; ++bj)
#pragma unroll
                    for (int n = 0; n < 2; ++n) *(LAS f32x4*)(lds + (wr * 64 + m * 16 + fr) * RP + (bj * HALF + wc * 32 + n * 16 + 4 * fq) * 4) = acc[ai][bj][m][n];
            asm volatile("s_waitcnt lgkmcnt(0)\n\ts_barrier" ::: "memory");
            float* orow = out + (size_t)(u.pm * BM + ai * HALF + wid * 16) * DM + u.pn * BM + 4 * lane;
#pragma unroll 4
            for (int r = 0; r < 16; ++r) { const f32x4 v = *(const LAS f32x4*)(lds + (wid * 16 + r) * RP + lane * 16); __builtin_nontemporal_store(v, (f32x4*)(orow + (size_t)r * DM)); }
            asm volatile("s_waitcnt lgkmcnt(0)\n\ts_barrier" ::: "memory");
        }
    }
};
}

constexpr int KROW = 288;
constexpr int ATT_K_OFF = 0;
constexpr int ATT_V_OFF = 256 * KROW;
constexpr int ATT_RS_OFF = ATT_V_OFF + 272 * KROW;
constexpr int ATT_G_OFF = ATT_RS_OFF + 512;
constexpr int N_ATT_UNITS = 3 * BATCH * 8 * 32;
static_assert(ATT_G_OFF + 1024 <= LDS_BYTES - 64, "attention LDS map");

__device__ __forceinline__ float dpp_f(float v, const int ctrl_dummy) { return v; }
#define DPP_ADD(v, ctrl) ((v) + __builtin_bit_cast(float, __builtin_amdgcn_update_dpp(0, __builtin_bit_cast(int, (v)), (ctrl), 0xF, 0xF, true)))

#define LDS_BARRIER() asm volatile("s_waitcnt lgkmcnt(0)\n\ts_barrier" ::: "memory")
struct AttnU { int g, b, h, r, blk, dsh; };
__device__ __forceinline__ AttnU attn_decode(int u) {
    AttnU U; U.g = u >> 9; const int rem = u & 511; U.b = rem >> 8; U.h = (rem >> 5) & 7; const int sub = rem & 31;
    U.dsh = 2 * U.g; const int nbsh = 5 - U.dsh; U.r = sub >> nbsh; U.blk = sub & ((1 << nbsh) - 1); return U;
}
__device__ __forceinline__ const bf16_t* attn_kslab(const bf16_t* qkv, const AttnU& U) { return qkv + ((size_t)((1 * 2 + U.b) * 3 + U.g) * 8 + U.h) * HSZ; }

struct AttnRegs { u32x4 rawk[4], rawv[4], rk2lo, rk2hi, rawq[4]; f32x4 kc0, kc1, ksn0, ksn1, qc0, qc1, qs0, qs1; };
__device__ __forceinline__ void attn_issue_kv(const bf16_t* __restrict__ qkv, const AttnU& U, int blkidx, AttnRegs& R) {
    const int tid = threadIdx.x, chunk = tid & 15, rowi = tid >> 4;
    const bf16_t* base = attn_kslab(qkv, U) + (size_t)((U.r << (12 - U.dsh)) + blkidx * 128) * HD;
#pragma unroll
    for (int p = 0; p < 4; ++p) { const bf16_t* rp = base + qkv_off(p * 32 + rowi, chunk); R.rawk[p] = *(const u32x4*)rp; R.rawv[p] = *(const u32x4*)(rp + 6 * 8 * HSZ); }
}
__device__ __forceinline__ void attn_issue_aux(const bf16_t* __restrict__ qkv, const float* __restrict__ ropec, const float* __restrict__ ropes, const AttnU& U, int blkidx, AttnRegs& R, bool withq) {
    const int tid = threadIdx.x;
    const bf16_t* base = attn_kslab(qkv, U) + (size_t)((U.r << (12 - U.dsh)) + blkidx * 128) * HD;
    const bf16_t* rp2 = base + qkv_off((tid >> 1) & 127, tid & 1);
    R.rk2lo = *(const u32x4*)rp2; R.rk2hi = *(const u32x4*)(rp2 + 16);
    const int t2 = (((blkidx * 128 + ((tid >> 1) & 127)) << U.dsh) + U.r) * 16 + (tid & 1) * 8;
    R.kc0 = *(const f32x4*)(ropec + t2); R.kc1 = *(const f32x4*)(ropec + t2 + 4); R.ksn0 = *(const f32x4*)(ropes + t2); R.ksn1 = *(const f32x4*)(ropes + t2 + 4);
    if (withq) {
        const int lane = tid & 63, fr = lane & 15, fq = lane >> 4, iq = 16 * (tid >> 6) + fr;
        const bf16_t* qp = attn_kslab(qkv, U) - 6 * 8 * HSZ + (size_t)((U.r << (12 - U.dsh)) + U.blk * 128) * HD + qkv_off(iq, fq);
#pragma unroll
        for (int ks = 0; ks < 4; ++ks) R.rawq[ks] = *(const u32x4*)(qp + ks * 512);
        const int tq = ((((U.blk * 128) + iq) << U.dsh) + U.r) * 16 + (fq & 1) * 8;
        R.qc0 = *(const f32x4*)(ropec + tq); R.qc1 = *(const f32x4*)(ropec + tq + 4); R.qs0 = *(const f32x4*)(ropes + tq); R.qs1 = *(const f32x4*)(ropes + tq + 4);
    }
}
__device__ __forceinline__ void attn_fill(LAS unsigned char* lds, int slot, const AttnRegs& R, const float* __restrict__ kg) {
    const int tid = threadIdx.x, chunk = tid & 15, rowi = tid >> 4;
    LAS float* rsl = (LAS float*)(lds + ATT_RS_OFF);
    float kgain[8];
    { const f32x4 g0 = *(const LAS f32x4*)(lds + ATT_G_OFF + 512 + chunk * 32), g1 = *(const LAS f32x4*)(lds + ATT_G_OFF + 512 + chunk * 32 + 16);
#pragma unroll
      for (int e = 0; e < 4; ++e) { kgain[e] = g0[e]; kgain[4 + e] = g1[e]; } }
#pragma unroll
    for (int p = 0; p < 4; ++p) {
        const int j = p * 32 + rowi;
        float v[8]; unpack8(R.rawk[p], v);
        float ss = 0.f;
#pragma unroll
        for (int e = 0; e < 8; ++e) ss += v[e] * v[e];
        ss = DPP_ADD(ss, 0xB1); ss = DPP_ADD(ss, 0x4E); ss = DPP_ADD(ss, 0x124); ss = DPP_ADD(ss, 0x128);
        const float rs = rsqrtf(ss * (1.0f / 128.0f) + NORM_EPS);
#pragma unroll
        for (int e = 0; e < 8; ++e) v[e] = v[e] * rs * kgain[e];
        if (chunk == 0) rsl[j] = rs;
        *(LAS u32x4*)(lds + ATT_K_OFF + (slot * 128 + j) * KROW + chunk * 16) = pack8(v);
        *(LAS u32x4*)(lds + ATT_V_OFF + (slot * 128 + j) * KROW + chunk * 16) = R.rawv[p];
    }
}
__device__ __forceinline__ void attn_rope(LAS unsigned char* lds, int slot, const AttnRegs& R, const float* __restrict__ kg) {
    const int tid = threadIdx.x; const f32x4 kc0 = R.kc0, kc1 = R.kc1, ksn0 = R.ksn0, ksn1 = R.ksn1;
    if (tid < 256) {
        const int j2 = tid >> 1, pr = tid & 1;
        const float rs = ((LAS float*)(lds + ATT_RS_OFF))[j2];
        float lo[8], hi[8], olo[8], ohi[8]; unpack8(R.rk2lo, lo); unpack8(R.rk2hi, hi);
#pragma unroll
        for (int e = 0; e < 8; ++e) { lo[e] = lo[e] * rs * ((const LAS float*)(lds + ATT_G_OFF + 512))[pr * 8 + e]; hi[e] = hi[e] * rs * ((const LAS float*)(lds + ATT_G_OFF + 512))[16 + pr * 8 + e]; }
#pragma unroll
        for (int e = 0; e < 4; ++e) {
            olo[e] = lo[e] * kc0[e] - hi[e] * ksn0[e]; ohi[e] = hi[e] * kc0[e] + lo[e] * ksn0[e];
            olo[4 + e] = lo[4 + e] * kc1[e] - hi[4 + e] * ksn1[e]; ohi[4 + e] = hi[4 + e] * kc1[e] + lo[4 + e] * ksn1[e]; }
        *(LAS u32x4*)(lds + ATT_K_OFF + (slot * 128 + j2) * KROW + pr * 16) = pack8(olo);
        *(LAS u32x4*)(lds + ATT_K_OFF + (slot * 128 + j2) * KROW + (pr + 2) * 16) = pack8(ohi);
    }
}
__device__ __forceinline__ void attn_phase(LAS unsigned char* lds, const bf16_t* __restrict__ qkv, const float* __restrict__ ropec, const float* __restrict__ ropes,
                                           const float* __restrict__ qg, const float* __restrict__ kg, bf16_t* __restrict__ O, float* __restrict__ lse, int u0, int nu, int flags) {
    const int tid = threadIdx.x, wid = __builtin_amdgcn_readfirstlane(tid >> 6), lane = tid & 63, fr = lane & 15, fq = lane >> 4;
    if (nu <= 0) return;
    for (int o = tid * 16; o < 272 * KROW; o += NTHREADS * 16) *(LAS u32x4*)(lds + ATT_V_OFF + o) = (u32x4){0u, 0u, 0u, 0u};
    for (int o = tid * 16; o < 256 * KROW; o += NTHREADS * 16) *(LAS u32x4*)(lds + ATT_K_OFF + o) = (u32x4){0u, 0u, 0u, 0u};
    if (tid < 128) ((LAS float*)(lds + ATT_G_OFF))[tid] = qg[tid]; else if (tid < 256) ((LAS float*)(lds + ATT_G_OFF))[tid] = kg[tid - 128];
    __syncthreads();
    int P = 0;
    AttnRegs R;
    {
        const AttnU U0 = attn_decode(u0);
        if (U0.blk > 0) {
            AttnRegs Rp;
            attn_issue_kv(qkv, U0, U0.blk - 1, Rp); attn_issue_aux(qkv, ropec, ropes, U0, U0.blk - 1, Rp, false);
            attn_issue_kv(qkv, U0, U0.blk, R); attn_issue_aux(qkv, ropec, ropes, U0, U0.blk, R, true);
            attn_fill(lds, P, Rp, kg);
            __syncthreads();
            attn_rope(lds, P, Rp, kg);
            __syncthreads();
        } else { attn_issue_kv(qkv, U0, U0.blk, R); attn_issue_aux(qkv, ropec, ropes, U0, U0.blk, R, true); }
    }
    for (int i = 0; i < nu; ++i) {
        const AttnU U = attn_decode(u0 + i);
        const int C = 1 - P;
        const int iq = 16 * wid + fr;
        const int tq = (((U.blk * 128) + iq) << U.dsh) + U.r;
        const size_t growq = (size_t)(U.b * SEQ + tq);
        const size_t hcol = (size_t)U.g * 1024 + U.h * 128;
        u32x4 rawq[4];
#pragma unroll
        for (int ks = 0; ks < 4; ++ks) rawq[ks] = R.rawq[ks];
        const f32x4 qc0 = R.qc0, qc1 = R.qc1, qs0 = R.qs0, qs1 = R.qs1;
        attn_fill(lds, C, R, kg);
        const bool more = (i + 1 < nu);
        const AttnU Un = attn_decode(u0 + (more ? i + 1 : i));
        attn_issue_kv(qkv, Un, Un.blk, R);
        LDS_BARRIER();
        attn_rope(lds, C, R, kg);
        bf16x8 qf[4];
        {
            float v[4][8]; float ss = 0.f;
#pragma unroll
            for (int ks = 0; ks < 4; ++ks) { unpack8(rawq[ks], v[ks]);
#pragma unroll
                for (int e = 0; e < 8; ++e) ss += v[ks][e] * v[ks][e]; }
            ss += __shfl_xor(ss, 16); ss += __shfl_xor(ss, 32);
            const float rs = rsqrtf(ss * (1.0f / 128.0f) + NORM_EPS);
#pragma unroll
            for (int ks = 0; ks < 4; ++ks)
#pragma unroll
                for (int e = 0; e < 8; ++e) v[ks][e] = v[ks][e] * rs * ((const LAS float*)(lds + ATT_G_OFF))[ks * 32 + fq * 8 + e];
            {
                float ot[8];
#pragma unroll
                for (int e = 0; e < 8; ++e) ot[e] = __shfl_xor(v[0][e], 32);
                const float sg = (fq < 2) ? -1.f : 1.f;
#pragma unroll
                for (int e = 0; e < 4; ++e) { v[0][e] = v[0][e] * qc0[e] + sg * ot[e] * qs0[e]; v[0][4 + e] = v[0][4 + e] * qc1[e] + sg * ot[4 + e] * qs1[e]; }
            }
#pragma unroll
            for (int ks = 0; ks < 4; ++ks) qf[ks] = __builtin_bit_cast(bf16x8, pack8(v[ks]));
        }
        attn_issue_aux(qkv, ropec, ropes, Un, Un.blk, R, true);
        LDS_BARRIER();
        f32x4 sacc[9];
#pragma unroll
        for (int t = 0; t < 9; ++t) {
            const int ta = wid + t; const int krow = (ta < 8) ? (P * 128 + 16 * ta) : (C * 128 + 16 * (ta - 8));
            sacc[t] = (f32x4){0.f, 0.f, 0.f, 0.f};
#pragma unroll
            for (int ks = 0; ks < 4; ++ks) { const bf16x8 a = *(const LAS bf16x8*)(lds + ATT_K_OFF + (krow + fr) * KROW + (ks * 32 + fq * 8) * 2);
                sacc[t] = __builtin_amdgcn_mfma_f32_16x16x32_bf16(a, qf[ks], sacc[t], 0, 0, 0); }
        }
        const float c2 = 0.08838834764831845f * 1.4426950408889634f;
        float mx = -INFINITY;
#pragma unroll
        for (int t = 0; t < 9; ++t) {
            const bool dead = (U.blk == 0) && (wid + t < 8);
#pragma unroll
            for (int i2 = 0; i2 < 4; ++i2) {
                bool valid = !dead;
                if (t == 0) valid = valid && (4 * fq + i2 >= fr);
                if (t == 8) valid = valid && (4 * fq + i2 <= fr);
                const float sv = valid ? sacc[t][i2] * c2 : -INFINITY; sacc[t][i2] = sv; mx = fmaxf(mx, sv); }
        }
        mx = fmaxf(mx, __shfl_xor(mx, 16)); mx = fmaxf(mx, __shfl_xor(mx, 32));
        float sum = 0.f;
#pragma unroll
        for (int t = 0; t < 9; ++t)
#pragma unroll
            for (int i2 = 0; i2 < 4; ++i2) { const float pv = __builtin_amdgcn_exp2f(sacc[t][i2] - mx); sacc[t][i2] = pv; sum += pv; }
        sum += __shfl_xor(sum, 16); sum += __shfl_xor(sum, 32);
        bf16x8 pf[5];
#pragma unroll
        for (int s2 = 0; s2 < 4; ++s2) { u32x4 w; w.x = cvt_pk_bf16(sacc[2 * s2][0], sacc[2 * s2][1]); w.y = cvt_pk_bf16(sacc[2 * s2][2], sacc[2 * s2][3]);
            w.z = cvt_pk_bf16(sacc[2 * s2 + 1][0], sacc[2 * s2 + 1][1]); w.w = cvt_pk_bf16(sacc[2 * s2 + 1][2], sacc[2 * s2 + 1][3]); pf[s2] = __builtin_bit_cast(bf16x8, w); }
        { u32x4 w; w.x = cvt_pk_bf16(sacc[8][0], sacc[8][1]); w.y = cvt_pk_bf16(sacc[8][2], sacc[8][3]); w.z = 0u; w.w = 0u; pf[4] = __builtin_bit_cast(bf16x8, w); }
        f32x4 o[8];
#pragma unroll
        for (int dt = 0; dt < 8; ++dt) o[dt] = (f32x4){0.f, 0.f, 0.f, 0.f};
#pragma unroll
        for (int s2 = 0; s2 < 5; ++s2) {
            const int ta = wid + 2 * s2, tb = ta + 1;
            const int rowa = (ta < 8) ? (P * 128 + 16 * ta) : (C * 128 + 16 * (ta - 8));
            const int rowb = (tb < 8) ? (P * 128 + 16 * tb) : ((tb < 16) ? (C * 128 + 16 * (tb - 8)) : 256);
            const LAS unsigned char* pa = lds + ATT_V_OFF + (rowa + 4 * fq + (fr >> 2)) * KROW + (4 * (fr & 3)) * 2;
            const LAS unsigned char* pb = lds + ATT_V_OFF + (rowb + 4 * fq + (fr >> 2)) * KROW + (4 * (fr & 3)) * 2;
#pragma unroll
            for (int dt = 0; dt < 8; ++dt) {
                const v4i16_t lo = __builtin_amdgcn_ds_read_tr16_b64_v4i16((LAS v4i16_t*)(pa + dt * 32));
                const v4i16_t hi = __builtin_amdgcn_ds_read_tr16_b64_v4i16((LAS v4i16_t*)(pb + dt * 32));
                const bf16x8 a = __builtin_shufflevector(lo, hi, 0, 1, 2, 3, 4, 5, 6, 7);
                o[dt] = __builtin_amdgcn_mfma_f32_16x16x32_bf16(a, pf[s2], o[dt], 0, 0, 0);
            }
        }
        const float inv = 1.0f / sum;
        bf16_t* op = O + growq * 3072 + hcol + 4 * fq;
#pragma unroll
        for (int k2 = 0; k2 < 4; ++k2) {
            u32x2 we, wo; we.x = cvt_pk_bf16(o[2 * k2][0] * inv, o[2 * k2][1] * inv); we.y = cvt_pk_bf16(o[2 * k2][2] * inv, o[2 * k2][3] * inv);
            wo.x = cvt_pk_bf16(o[2 * k2 + 1][0] * inv, o[2 * k2 + 1][1] * inv); wo.y = cvt_pk_bf16(o[2 * k2 + 1][2] * inv, o[2 * k2 + 1][3] * inv);
            const bool odd = fq & 1;
            u32x2 snd = odd ? we : wo, rcv; rcv.x = __shfl_xor(snd.x, 16); rcv.y = __shfl_xor(snd.y, 16);
            u32x4 w; if (odd) { w.x = rcv.x; w.y = rcv.y; w.z = wo.x; w.w = wo.y; } else { w.x = we.x; w.y = we.y; w.z = rcv.x; w.w = rcv.y; }
            *(u32x4*)(O + growq * 3072 + hcol + (2 * k2 + (odd ? 1 : 0)) * 16 + 4 * (fq & 2)) = w; }
        if (fq == 0) lse[growq * 24 + U.g * 8 + U.h] = (mx + __log2f(sum)) * 0.6931471805599453f;
        LDS_BARRIER();
        P = C;
    }
}

#define XB_TMO      128
#define XB_XCNT(j)  (256  + 64 * (j))
#define XB_XSUB(j)  (1280 + 64 * (j))
#define XB_XGEN(j)  (2304 + 64 * (j))
#define XB_TOP      3328
#define XB_TOPGEN   3392
#define XCD_BAR_WORDS 3456
#define XB_SPIN_CAP (1u << 22)
__device__ __forceinline__ unsigned xb_ld(unsigned* p)              { return __hip_atomic_load(p, __ATOMIC_RELAXED, __HIP_MEMORY_SCOPE_AGENT); }
__device__ __forceinline__ unsigned xb_add(unsigned* p, unsigned v) { return __hip_atomic_fetch_add(p, v, __ATOMIC_RELAXED, __HIP_MEMORY_SCOPE_AGENT); }
__device__ __forceinline__ unsigned xb_xcc_id() { return (unsigned)__builtin_amdgcn_s_getreg((3 << 11) | 20) & 0xFu; }
#define XB_SPIN(cond, bar) do { unsigned _sp = 0; while (cond) { __builtin_amdgcn_s_sleep(1); \
    if ((++_sp & 255u) == 0u) { if (xb_ld(&(bar)[XB_TMO])) break; if (_sp > XB_SPIN_CAP) { atomicAdd(&(bar)[XB_TMO], 1u); break; } } } } while (0)
struct XcdBarrier { unsigned* bar; unsigned x; volatile LAS unsigned* st; };
__device__ __forceinline__ XcdBarrier xcd_barrier_post(unsigned* bar, volatile LAS unsigned* st) {
    XcdBarrier b; b.bar = bar; b.x = xb_xcc_id(); b.st = st;
    if (threadIdx.x == 0) (void)xb_add(&bar[XB_XCNT(b.x)], 1u);
    return b;
}
__device__ __forceinline__ void xcd_barrier_complete(unsigned* bar, unsigned x, unsigned& nloc, unsigned& nx) {
    const unsigned G = gridDim.x * gridDim.y * gridDim.z;
    unsigned sum, cnt, mine, sp = 0u;
    for (;;) {
        sum = 0u; cnt = 0u; mine = 0u;
#pragma unroll
        for (unsigned j = 0; j < 16; ++j) { const unsigned c = xb_ld(&bar[XB_XCNT(j)]); sum += c; cnt += (c > 0u) ? 1u : 0u; mine = (j == x) ? c : mine; }
        if (sum == G) break;
        __builtin_amdgcn_s_sleep(1);
        if ((++sp & 255u) == 0u) { if (xb_ld(&bar[XB_TMO])) break; if (sp > XB_SPIN_CAP) { atomicAdd(&bar[XB_TMO], 1u); break; } }
    }
    nloc = mine > 0u ? mine : 1u; nx = cnt > 0u ? cnt : 1u;
}
__device__ __forceinline__ void xcd_barrier(const XcdBarrier& b) {
    asm volatile("s_waitcnt vmcnt(0)" ::: "memory");
    __syncthreads();
    if (threadIdx.x == 0) {
        unsigned* bar = b.bar;
        __builtin_amdgcn_s_waitcnt(0);
        unsigned nloc = b.st[0], nx = b.st[1];
        if (nloc == 0u) { xcd_barrier_complete(bar, b.x, nloc, nx); b.st[0] = nloc; b.st[1] = nx; }
        const unsigned old = xb_add(&bar[XB_XSUB(b.x)], 1u);
        const unsigned gen = old / nloc;
        if (old + 1u == (gen + 1u) * nloc) {
            __builtin_amdgcn_fence(__ATOMIC_RELEASE, "agent");
            asm volatile("s_waitcnt vmcnt(0)" ::: "memory");
            const unsigned og = xb_add(&bar[XB_TOP], 1u);
            const unsigned tg = og / nx;
            if (og + 1u == (tg + 1u) * nx) xb_add(&bar[XB_TOPGEN], 1u);
            else XB_SPIN(xb_ld(&bar[XB_TOPGEN]) == tg, bar);
            __builtin_amdgcn_fence(__ATOMIC_ACQUIRE, "agent");
            xb_add(&bar[XB_XGEN(b.x)], 1u);
            asm volatile("s_waitcnt vmcnt(0)" ::: "memory");
        } else {
            XB_SPIN(xb_ld(&bar[XB_XGEN(b.x)]) == gen, bar);
            __builtin_amdgcn_fence(__ATOMIC_ACQUIRE, "agent");
            asm volatile("s_waitcnt vmcnt(0)" ::: "memory");
        }
    }
    __syncthreads();
}

template <int KSZ> __device__ __forceinline__ void pool_diff_run(const bf16_t* __restrict__ PROJ, bf16_t* __restrict__ DB, int row0, int ch) {
    const int s0 = row0 & (SEQ - 1);
    const bf16_t* up = PROJ + (size_t)row0 * LDP + C_U + ch * 8;
    u32x4 raw[KSZ + 7];
#pragma unroll
    for (int i = 0; i < KSZ + 7; ++i) { const int d = (KSZ - 1) - i;
        raw[i] = (d <= s0) ? *(const u32x4*)(up - (ptrdiff_t)d * LDP) : (u32x4){0u, 0u, 0u, 0u}; }
    float W[8];
#pragma unroll
    for (int e = 0; e < 8; ++e) W[e] = 0.f;
#pragma unroll
    for (int i = 0; i < KSZ - 1; ++i) { float t[8]; unpack8(raw[i], t);
#pragma unroll
        for (int e = 0; e < 8; ++e) W[e] += t[e]; }
#pragma unroll
    for (int k = 0; k < 8; ++k) {
        float cur[8], old[8], o[8]; unpack8(raw[KSZ - 1 + k], cur); unpack8(raw[k], old);
        const int cnt = (s0 + k + 1 < KSZ) ? (s0 + k + 1) : KSZ; const float ic = 1.0f / (float)cnt;
#pragma unroll
        for (int e = 0; e < 8; ++e) { W[e] += cur[e]; o[e] = W[e] * ic - cur[e]; W[e] -= old[e]; }
        *(u32x4*)(DB + (size_t)(row0 + k) * 1024 + ch * 8) = pack8(o);
    }
}

template <int NQ> __device__ __forceinline__ void mix_rows(const bf16_t* __restrict__ OB, const float* __restrict__ LSE, const bf16_t* __restrict__ PROJ, bf16_t* __restrict__ A12, int rowb) {
    const int tid = threadIdx.x;
    u32x4 ra0[NQ], ra1[NQ], ra2[NQ], rz[NQ]; float l0[NQ], l1[NQ], l2[NQ];
#pragma unroll
    for (int q = 0; q < NQ; ++q) { const int it = q * NTHREADS + tid, row = rowb + (it >> 7), ch = it & 127, h = ch >> 4;
        l0[q] = LSE[(size_t)row * 24 + h]; l1[q] = LSE[(size_t)row * 24 + 8 + h]; l2[q] = LSE[(size_t)row * 24 + 16 + h];
        const bf16_t* op = OB + (size_t)row * 3072 + ch * 8;
        ra0[q] = *(const u32x4*)op; ra1[q] = *(const u32x4*)(op + 1024); ra2[q] = *(const u32x4*)(op + 2048);
        rz[q] = *(const u32x4*)(PROJ + (size_t)row * LDP + C_ZA + ch * 8); }
#pragma unroll
    for (int q = 0; q < NQ; ++q) { const int it = q * NTHREADS + tid, row = rowb + (it >> 7), ch = it & 127;
        const float mxl = fmaxf(l0[q], fmaxf(l1[q], l2[q]));
        float w0 = __expf(l0[q] - mxl), w1 = __expf(l1[q] - mxl), w2 = __expf(l2[q] - mxl); const float iw = 1.0f / (w0 + w1 + w2); w0 *= iw; w1 *= iw; w2 *= iw;
        float a0[8], a1[8], a2[8], z[8], r[8];
        unpack8(ra0[q], a0); unpack8(ra1[q], a1); unpack8(ra2[q], a2); unpack8(rz[q], z);
#pragma unroll
        for (int e = 0; e < 8; ++e) r[e] = (w0 * a0[e] + w1 * a1[e] + w2 * a2[e]) * z[e];
        *(u32x4*)(A12 + (size_t)row * 2048 + ch * 8) = pack8(r); }
}

__device__ __forceinline__ unsigned f2bf(float f) { unsigned u = __builtin_bit_cast(unsigned, f); return (u + 0x7fffu + ((u >> 16) & 1u)) >> 16; }
__device__ __forceinline__ unsigned pk2(float lo, float hi) { return f2bf(lo) | (f2bf(hi) << 16); }
__device__ __forceinline__ void transpose_item(const float* __restrict__ W, int ldw, bf16_t* __restrict__ WT, int ldt, LAS float* scr, int kb, int nb, int lane) {
    const int k0 = 64 * kb, n0 = 32 * nb;
#pragma unroll 8
    for (int i = 0; i < 32; ++i) { const int kk = 2 * i + (lane >> 5); scr[kk * 33 + (lane & 31)] = __builtin_nontemporal_load(W + (size_t)(k0 + kk) * ldw + n0 + (lane & 31)); }
    asm volatile("s_waitcnt lgkmcnt(0)" ::: "memory");
    const int c = lane & 7;
#pragma unroll
    for (int j = 0; j < 4; ++j) { const int n = (lane >> 3) + 8 * j; const LAS float* s = scr + (8 * c) * 33 + n;
        u32x4 o; o.x = pk2(s[0 * 33], s[1 * 33]); o.y = pk2(s[2 * 33], s[3 * 33]); o.z = pk2(s[4 * 33], s[5 * 33]); o.w = pk2(s[6 * 33], s[7 * 33]);
        *(u32x4*)(WT + (size_t)(n0 + n) * ldt + k0 + 8 * c) = o; }
    asm volatile("s_waitcnt lgkmcnt(0)" ::: "memory");
}

struct Args { const float* in[11]; float* out; unsigned char* ws; int ph_lo, ph_hi, flags, pad; };

__global__ void __launch_bounds__(NTHREADS, 2) fwd_kernel(Args args) {
    extern __shared__ __attribute__((aligned(16))) unsigned char lds_raw[];
    LAS unsigned char* lds = (LAS unsigned char*)lds_raw;
    const int tid = threadIdx.x, lane = tid & 63, wave = __builtin_amdgcn_readfirstlane(tid >> 6);
    const int G = gridDim.x, bx = blockIdx.x;
    const int lo = args.ph_lo, hi = args.ph_hi;
    unsigned char* ws = args.ws;
    const float* x = args.in[0]; const float* norm_gain = args.in[1]; const float* w_in = args.in[2]; const float* b_gates = args.in[3];
    const float* q_gain = args.in[4]; const float* k_gain = args.in[5]; const float* pool_maps = args.in[6]; const float* pool_scale = args.in[7];
    const float* w_ba = args.in[8]; const float* w_bp = args.in[9]; const float* w_out = args.in[10];
    bf16_t* WinT = (bf16_t*)(ws + WS_WIN); bf16_t* W12T = (bf16_t*)(ws + WS_W12); bf16_t* WoT = (bf16_t*)(ws + WS_WO); bf16_t* PMT = (bf16_t*)(ws + WS_PM);
    float* ropec = (float*)(ws + WS_ROPE); float* ropes = ropec + 4096 * 16;
    bf16_t* XN = (bf16_t*)(ws + WS_XN); bf16_t* PROJ = (bf16_t*)(ws + WS_PROJ); bf16_t* ZPF = (bf16_t*)(ws + WS_ZPF); bf16_t* GF = (bf16_t*)(ws + WS_GF); bf16_t* QKVH = (bf16_t*)(ws + WS_QKV); bf16_t* OB = (bf16_t*)(ws + WS_O); float* LSE = (float*)(ws + WS_LSE);
    bf16_t* DB = (bf16_t*)(ws + WS_D); bf16_t* A12 = (bf16_t*)(ws + WS_A12); bf16_t* MG = (bf16_t*)(ws + WS_MG);
    volatile LAS unsigned* MISC = (volatile LAS unsigned*)(lds + LDS_BYTES - 64);
    if (tid < 16) MISC[tid] = 0u;
    __syncthreads();
    XcdBarrier bar; bar.bar = (unsigned*)(ws + WS_CTL); bar.x = 0; bar.st = nullptr;
    if (hi - lo > 1) bar = xcd_barrier_post((unsigned*)(ws + WS_CTL), MISC);
#define IN(k) (lo <= (k) && (k) < hi)
#define SEAM(k) do { if (IN(k) && IN((k) + 1)) { xcd_barrier(bar); } } while (0)

    if (IN(0)) {
        LAS float* scr = (LAS float*)(lds + wave * 16384);
        const int gw = bx * NWAVES + wave, NGW = G * NWAVES;
        constexpr int I_IN = 32 * 512, I_BA = 16 * 64, I_BP = 16 * 64, I_O = 32 * 64, I_PM = 4 * 32;
        constexpr int NITEMS = I_IN + I_BA + I_BP + I_O + I_PM;
        for (int it = gw; it < NITEMS; it += NGW) {
            int r = it;
            if (r < I_IN) { transpose_item(w_in, INC, WinT, 2048, scr, r / 512, r % 512, lane); continue; } r -= I_IN;
            if (r < I_BA) { transpose_item(w_ba, 2048, W12T, 2048, scr, r / 64, r % 64, lane); continue; } r -= I_BA;
            if (r < I_BP) { transpose_item(w_bp, 2048, W12T + 1024, 2048, scr, r / 64, r % 64, lane); continue; } r -= I_BP;
            if (r < I_O) { transpose_item(w_out, 2048, WoT, 2048, scr, r / 64, r % 64, lane); continue; } r -= I_O;
            { const int gi = r >> 5, rr = r & 31; transpose_item(pool_maps + (size_t)gi * 65536, 256, PMT + (size_t)gi * 65536, 256, scr, rr >> 3, rr & 7, lane); }
        }
        for (int m = gw; m < M; m += NGW) {
            const f32x4* xr = (const f32x4*)(x + (size_t)m * DM) + lane;
            f32x4 v[8]; float s = 0.f;
#pragma unroll
            for (int j = 0; j < 8; ++j) { v[j] = __builtin_nontemporal_load(xr + 64 * j); s += (v[j].x * v[j].x + v[j].y * v[j].y) + (v[j].z * v[j].z + v[j].w * v[j].w); }
#pragma unroll
            for (int o = 1; o < 64; o <<= 1) s += __shfl_xor(s, o);
            const float rs = rsqrtf(s * (1.0f / DM) + NORM_EPS);
            u32x2* o8 = (u32x2*)(XN + (size_t)m * DM) + lane;
#pragma unroll
            for (int j = 0; j < 8; ++j) { const f32x4 gn = *((const f32x4*)norm_gain + lane + 64 * j); u32x2 w; w.x = cvt_pk_bf16(v[j].x * rs * gn.x, v[j].y * rs * gn.y); w.y = cvt_pk_bf16(v[j].z * rs * gn.z, v[j].w * rs * gn.w); o8[64 * j] = w; }
        }
        {
            const float invf[16] = {1.000000000e+00f, 4.403665960e-01f, 1.939227432e-01f, 8.539710194e-02f, 3.760603070e-02f, 1.656043902e-02f, 7.292664610e-03f, 3.211445874e-03f,
                                    1.414213562e-03f, 6.227723788e-04f, 2.742481884e-04f, 1.207697351e-04f, 5.318296098e-05f, 2.341999971e-05f, 1.031338616e-05f, 4.541670478e-06f};
            for (int idx = bx * NTHREADS + tid; idx < 4096 * 16; idx += G * NTHREADS) {
                const int pos = idx >> 4, j = idx & 15;
                float f = invf[0];
#pragma unroll
                for (int q = 1; q < 16; ++q) f = (j == q) ? invf[q] : f;
                const float ang = (float)pos * f;
                double rev = (double)ang * 0.15915494309189535; rev -= __builtin_rint(rev);
                const float rf = (float)rev;
                ropec[idx] = __builtin_amdgcn_cosf(rf); ropes[idx] = __builtin_amdgcn_sinf(rf);
            }
        }
        __syncthreads();
    }
    SEAM(0);

    if (IN(1)) {
        pg8::Gemm g{XN, WinT, 2048, 2048, 2048}; pg8::SchedStd S{M / 256, INC / 256, G, bx};
        pg8::EpiProj E{PROJ, QKVH, b_gates, ZPF, GF};
        pg8::gemm_phase<pg8::EpiProj, pg8::SchedStd, true>(lds, g, S, E);
    }
    SEAM(1);

    if (IN(2)) {
        const bool has_pool = bx < 128;
        if (has_pool && !(args.flags & 2)) {
            const int pm = bx >> 2, pg = bx & 3;
            u32x4 wm[8];
#pragma unroll
            for (int q = 0; q < 4; ++q) wm[q] = *(const u32x4*)(PMT + (size_t)pg * 65536 + (size_t)(q * NTHREADS + tid) * 32);
#pragma unroll
            for (int q = 0; q < 4; ++q) { const int it = q * NTHREADS + tid, rr = it >> 3, cc = it & 7;
                (void)rr; (void)cc; wm[4 + q] = *(const u32x4*)(ZPF + (size_t)(pm * 4 + pg) * 65536 + (size_t)it * 32); }
#pragma unroll
            for (int q = 0; q < 2; ++q) { const int it = q * NTHREADS + tid, run = it >> 5, ch = pg * 32 + (it & 31), row0 = pm * 256 + run * 8;
                if (pg == 0) pool_diff_run<2>(PROJ, DB, row0, ch); else if (pg == 1) pool_diff_run<4>(PROJ, DB, row0, ch);
                else if (pg == 2) pool_diff_run<8>(PROJ, DB, row0, ch); else pool_diff_run<16>(PROJ, DB, row0, ch); }
#pragma unroll
            for (int q = 0; q < 8; ++q) asm volatile("" :: "v"(wm[q]));
            asm volatile("s_waitcnt vmcnt(0)" ::: "memory");
            __syncthreads();
            pg8::Gemm g{DB, PMT, 1024, 256, 256}; pg8::SchedPool S{G, bx};
            pg8::EpiPool E{A12, ZPF, pool_scale};
            pg8::gemm_phase<pg8::EpiPool, pg8::SchedPool, true>(lds, g, S, E);
            __syncthreads();
        }
        if (!(args.flags & 1)) {
            const int u0 = has_pool ? bx * 4 : 512 + (bx - 128) * 8, nu = has_pool ? 4 : 8;
            attn_phase(lds, QKVH, ropec, ropes, q_gain, k_gain, OB, LSE, u0, nu, args.flags);
        }
    }
    SEAM(2);

    if (IN(3)) {
        for (int rb = bx * 16; rb < M; rb += G * 16) mix_rows<4>(OB, LSE, PROJ, A12, rb);
    }
    SEAM(3);

    if (IN(4)) {
        pg8::Gemm g{A12, W12T, 2048, 2048, 1024}; pg8::SchedDual S{M / 256, DM / 256, G, bx};
        pg8::EpiGate E{MG, GF};
        pg8::gemm_phase<pg8::EpiGate, pg8::SchedDual, true>(lds, g, S, E);
    }
    SEAM(4);

    if (IN(5)) {
        pg8::Gemm g{MG, WoT, 2048, 2048, 2048}; pg8::SchedStd S{M / 256, DM / 256, G, bx};
        pg8::EpiRes E{x, args.out};
        pg8::gemm_phase<pg8::EpiRes, pg8::SchedStd, false>(lds, g, S, E);
    }
#undef IN
#undef SEAM
}

extern "C" void kernel_launch(void* const* d_in, const int* in_sizes, int n_in, void* d_out, int out_size, void* d_ws, size_t ws_size, hipStream_t stream) {
    static int grid = 0;
    if (grid == 0) {
        if (n_in != 11 || ws_size < WS_END) { fprintf(stderr, "kernel_launch: unexpected problem (n_in %d, ws %zu)\n", n_in, ws_size); grid = -1; return; }
        int dev = 0, cus = 0, per_cu = 0;
        hipGetDevice(&dev); hipDeviceGetAttribute(&cus, hipDeviceAttributeMultiprocessorCount, dev);
        if (hipFuncSetAttribute((const void*)fwd_kernel, hipFuncAttributeMaxDynamicSharedMemorySize, LDS_BYTES) != hipSuccess) { fprintf(stderr, "kernel_launch: hipFuncSetAttribute failed\n"); grid = -1; return; }
        if (hipOccupancyMaxActiveBlocksPerMultiprocessor(&per_cu, (const void*)fwd_kernel, NTHREADS, LDS_BYTES) != hipSuccess || per_cu < 1) { fprintf(stderr, "kernel_launch: occupancy query says %d\n", per_cu); per_cu = 1; }
        (void)hipGetLastError();
        grid = cus;
        if (grid != 256) { fprintf(stderr, "kernel_launch: built for a 256-CU device (work split over exactly 256 workgroups), found %d CUs; nothing launched\n", cus); grid = -1; return; }
        fprintf(stderr, "kernel_launch: grid %d (per_cu %d)\n", grid, per_cu);
    }
    if (grid < 0) return;
    if (hipMemsetAsync((char*)d_ws + WS_CTL, 0, 65536, stream) != hipSuccess) { fprintf(stderr, "kernel_launch: memset failed\n"); return; }
    Args a{};
    for (int i = 0; i < 11; ++i) a.in[i] = (const float*)d_in[i];
    a.out = (float*)d_out; a.ws = (unsigned char*)d_ws;
#if MK_N_LAUNCHES == 1
    a.ph_lo = 0; a.ph_hi = 6;
    void* kargs[] = {&a};
    hipError_t e = hipLaunchCooperativeKernel((const void*)fwd_kernel, dim3(grid), dim3(NTHREADS), kargs, LDS_BYTES, stream);
    if (e != hipSuccess) fprintf(stderr, "cooperative launch failed: %s (grid %d)\n", hipGetErrorString(e), grid);
#if PROBE_PHASE >= 0
    a.ph_lo = PROBE_PHASE; a.ph_hi = PROBE_PHASE + 1; a.flags = PROBE_FLAGS; for (int rep = 0; rep < PROBE_REPS; ++rep) hipLaunchKernelGGL(fwd_kernel, dim3(grid), dim3(NTHREADS), LDS_BYTES, stream, a);
#endif
#else
    for (int p = 0; p < 6; ++p) { a.ph_lo = p; a.ph_hi = p + 1; hipLaunchKernelGGL(fwd_kernel, dim3(grid), dim3(NTHREADS), LDS_BYTES, stream, a); }
#endif
}
```

```cpp
#include <hip/hip_runtime.h>
#include <hip/hip_cooperative_groups.h>
#include <cstdio>
#include <cstdint>
namespace cg = cooperative_groups;

#ifndef MK_N_LAUNCHES
#define MK_N_LAUNCHES 1
#endif

#ifndef PROBE_PHASE
#define PROBE_PHASE -1
#endif
#ifndef PROBE_REPS
#define PROBE_REPS 1
#endif
#ifndef PROBE_FLAGS
#define PROBE_FLAGS 0
#endif

#define LAS __attribute__((address_space(3)))
typedef unsigned short bf16_t;
typedef short bf16x8 __attribute__((ext_vector_type(8)));
typedef short v4i16_t __attribute__((ext_vector_type(4)));
typedef float f32x4 __attribute__((ext_vector_type(4)));
typedef unsigned u32x4 __attribute__((ext_vector_type(4)));
typedef unsigned u32x2 __attribute__((ext_vector_type(2)));

constexpr int BATCH = 2, SEQ = 4096, DM = 2048, M = BATCH * SEQ, INC = 16384, HD = 128;
constexpr int LDP = 2048;
constexpr int C_ZA = 0, C_U = 1024;
__host__ __device__ __forceinline__ size_t frag_off(int tile, int k, int wave, int lane) { return ((((size_t)tile * 16 + k) * 8 + wave) * 64 + lane) * 8; }
__host__ __device__ __forceinline__ size_t qkv_off(int row, int chunk  ) { return (size_t)(row >> 4) * 2048 + (size_t)(chunk >> 2) * 512 + (size_t)(row & 15) * 32 + (size_t)(chunk & 3) * 8; }
constexpr size_t HSZ = (size_t)SEQ * HD;

constexpr float NORM_EPS = 1e-6f;
constexpr int NTHREADS = 512, NWAVES = 8;

constexpr size_t MiB = 1u << 20;
constexpr size_t WS_CTL = 0;
constexpr size_t WS_WIN = 2 * MiB;
constexpr size_t WS_W12 = 66 * MiB;
constexpr size_t WS_WO = 74 * MiB;
constexpr size_t WS_PM = 82 * MiB;
constexpr size_t WS_ROPE = 83 * MiB;
constexpr size_t WS_XN = 84 * MiB;
constexpr size_t WS_PROJ = 116 * MiB;
constexpr size_t WS_ZPF = 148 * MiB;
constexpr size_t WS_GF = 164 * MiB;
constexpr size_t WS_QKV = 228 * MiB;
constexpr size_t WS_O = 372 * MiB;
constexpr size_t WS_LSE = 420 * MiB;
constexpr size_t WS_D = 422 * MiB;
constexpr size_t WS_A12 = 438 * MiB;
constexpr size_t WS_MG = 470 * MiB;
constexpr size_t WS_END = 502 * MiB;

constexpr int LDS_BYTES = 152 * 1024;

__device__ __forceinline__ unsigned cvt_pk_bf16(float lo, float hi) { unsigned r; asm volatile("v_cvt_pk_bf16_f32 %0, %1, %2" : "=v"(r) : "v"(lo), "v"(hi)); return r; }
__device__ __forceinline__ float bf_lo(unsigned w) { return __uint_as_float(w << 16); }
__device__ __forceinline__ float bf_hi(unsigned w) { return __uint_as_float(w & 0xffff0000u); }
__device__ __forceinline__ float fast_sigmoid(float v) { return __builtin_amdgcn_rcpf(1.0f + __builtin_amdgcn_exp2f(-1.4426950408889634f * v)); }
__device__ __forceinline__ void unpack8(const u32x4 w, float (&v)[8]) {
    v[0] = bf_lo(w.x); v[1] = bf_hi(w.x); v[2] = bf_lo(w.y); v[3] = bf_hi(w.y); v[4] = bf_lo(w.z); v[5] = bf_hi(w.z); v[6] = bf_lo(w.w); v[7] = bf_hi(w.w);
}
__device__ __forceinline__ u32x4 pack8(const float (&v)[8]) {
    u32x4 w; w.x = cvt_pk_bf16(v[0], v[1]); w.y = cvt_pk_bf16(v[2], v[3]); w.z = cvt_pk_bf16(v[4], v[5]); w.w = cvt_pk_bf16(v[6], v[7]); return w;
}

namespace pg8 {
constexpr int BM = 256, BK = 64, HALF = 128, HTB = HALF * BK * 2, STAGE_BYTES = 8 * HTB, NXCD = 8, WGM = 8;
__host__ __device__ __forceinline__ int lds_byte(int r, int c) { const int st = (r >> 4) * 2 + (c >> 5), rr = r & 15, cc = c & 31, ob = rr * 64 + cc * 2; return st * 1024 + (ob ^ (((ob >> 9) & 1) << 5)); }
__host__ __device__ __forceinline__ void stage_rc(int b, int& R, int& C) { const int st = b / 1024, sb = b % 1024, swz = sb ^ (((sb >> 9) & 1) << 5); R = (st >> 1) * 16 + swz / 64; C = (st & 1) * 32 + (swz % 64) / 2; }
__host__ __device__ __forceinline__ int perm32(int rho) { const int n = rho >> 4, i = rho & 15; return 8 * (i >> 2) + 4 * n + (i & 3); }

struct Unit { int pm, pn, acol, bcol, tag, keep; };
struct Gemm { const bf16_t* A; const bf16_t* Bt; int lda, ldb, K; };

__device__ __forceinline__ void tile_of(int L, int nM, int nN, int& pm, int& pn) {
    const int nwg = nM * nN; int wgid = L;
    { const int q = nwg / NXCD, r = nwg % NXCD, xcd = wgid % NXCD, off = wgid / NXCD; wgid = (xcd < r ? xcd * (q + 1) : r * (q + 1) + (xcd - r) * q) + off; }
    const int nig = WGM * nN, gid = wgid / nig, fm = gid * WGM, gsz = (nM - fm) < WGM ? (nM - fm) : WGM;
    pm = fm + ((wgid % nig) % gsz); pn = (wgid % nig) / gsz;
}
struct SchedStd {
    int nM, nN, G, c;
    __device__ __forceinline__ bool next(int i, Unit& u) const { const long L = (long)i * G + c; if (L >= (long)nM * nN) return false; tile_of((int)L, nM, nN, u.pm, u.pn); u.acol = 0; u.bcol = 0; u.tag = 0; u.keep = 0; return true; }
};
struct SchedPool {
    int G, c;
    __device__ __forceinline__ bool next(int i, Unit& u) const { const int L = i * G + c; if (L >= 128) return false; u.pm = L >> 2; u.pn = L & 3; u.acol = u.pn * 256; u.bcol = 0; u.tag = 0; u.keep = 0; return true; }
};
struct SchedDual {
    int nM, nN, G, c;
    __device__ __forceinline__ bool next(int i, Unit& u) const { const long L = (long)(i >> 1) * G + c; if (L >= (long)nM * nN) return false; tile_of((int)L, nM, nN, u.pm, u.pn); u.tag = i & 1; u.acol = u.bcol = u.tag * 1024; u.keep = (u.tag == 0); return true; }
};

template <class Epi, class Sched, bool ALIGN_EPI>
__device__ __forceinline__ void gemm_phase(LAS unsigned char* lds, const Gemm g, const Sched& S, const Epi& E) {
    const int tid = threadIdx.x, wid = __builtin_amdgcn_readfirstlane(tid >> 6), lane = tid & 63, wr = wid >> 2, wc = wid & 3, fr = lane & 15, fq = lane >> 4;
    const int nt = g.K / BK;
    unsigned voffA[2], voffB[2];
#pragma unroll
    for (int i = 0; i < 2; ++i) { int R, C; stage_rc(tid * 16 + i * 8192, R, C); const int Rb = Epi::PERM ? ((R & ~31) + perm32(R & 31)) : R;
        voffA[i] = (unsigned)(R * g.lda + C) * 2u; voffB[i] = (unsigned)(Rb * g.ldb + C) * 2u; }
    const size_t kstep = (size_t)(BK * 2);
    const size_t hsA = (size_t)HALF * g.lda * 2, hsB = (size_t)HALF * g.ldb * 2;
    const unsigned ldsw = (unsigned)wid * 1024u;
    const int aoff = lds_byte(wr * 64 + fr, fq * 8), boff = lds_byte(wc * 32 + fr, fq * 8);
#define PG8_SA(b, h) (((b) * 2 + (h)) * HTB)
#define PG8_SB(b, h) ((4 + (b) * 2 + (h)) * HTB)
#define PG8_STAGE(bufoff, gbase, voff) do { _Pragma("unroll") for (int _i = 0; _i < 2; ++_i) \
        __builtin_amdgcn_global_load_lds((const unsigned*)((const char*)(gbase) + (voff)[_i]), (LAS unsigned*)(lds + (bufoff) + ldsw + _i * 8192), 16, 0, 0); } while (0)
#define PG8_LDA(dst, b, h) do { _Pragma("unroll") for (int m = 0; m < 4; ++m) _Pragma("unroll") for (int k = 0; k < 2; ++k) dst[m][k] = *(const LAS bf16x8*)(lds + PG8_SA(b, h) + aoff + m * 2048 + k * 1024); } while (0)
#define PG8_LDB(dst, b, h) do { _Pragma("unroll") for (int n = 0; n < 2; ++n) _Pragma("unroll") for (int k = 0; k < 2; ++k) dst[n][k] = *(const LAS bf16x8*)(lds + PG8_SB(b, h) + boff + n * 2048 + k * 1024); } while (0)
#define PG8_MMA(ai, bj, At, Bt) do { __builtin_amdgcn_s_setprio(1); _Pragma("unroll") for (int m = 0; m < 4; ++m) _Pragma("unroll") for (int n = 0; n < 2; ++n) _Pragma("unroll") for (int k = 0; k < 2; ++k) \
        acc[ai][bj][m][n] = __builtin_amdgcn_mfma_f32_16x16x32_bf16(Bt[n][k], At[m][k], acc[ai][bj][m][n], 0, 0, 0); __builtin_amdgcn_s_setprio(0); } while (0)
#define PG8_WAIT_V(n) asm volatile("s_waitcnt vmcnt(" #n ")" ::: "memory")
#define PG8_WAIT_L(n) asm volatile("s_waitcnt lgkmcnt(" #n ")" ::: "memory")
#define PG8_BAR __builtin_amdgcn_s_barrier()
#define PG8_SCHED __builtin_amdgcn_sched_barrier(0)
    Unit cur, nxt; int ui = 0;
    if (!S.next(0, cur)) return;
    f32x4 acc[2][2][4][2];
#pragma unroll
    for (int a = 0; a < 2; ++a)
#pragma unroll
        for (int b = 0; b < 2; ++b)
#pragma unroll
            for (int m = 0; m < 4; ++m)
#pragma unroll
                for (int n = 0; n < 2; ++n) acc[a][b][m][n] = (f32x4){0.f, 0.f, 0.f, 0.f};
    if constexpr (Epi::PRELOAD) E.init(acc, cur, wr, wc, fr, fq);
    bf16x8 At[4][2], B0[2][2], B1[2][2];
    const char* cA = (const char*)g.A + ((size_t)cur.pm * BM * g.lda + cur.acol) * 2; const char* cB = (const char*)g.Bt + ((size_t)cur.pn * BM * g.ldb + cur.bcol) * 2;
    PG8_STAGE(PG8_SB(0, 0), cB, voffB); PG8_STAGE(PG8_SB(0, 1), cB + hsB, voffB); PG8_STAGE(PG8_SA(0, 0), cA, voffA); PG8_STAGE(PG8_SA(0, 1), cA + hsA, voffA);
    if (wr == 1) PG8_BAR;
    PG8_WAIT_V(2); PG8_BAR;
    PG8_STAGE(PG8_SB(1, 0), cB + kstep, voffB); PG8_STAGE(PG8_SA(1, 0), cA + kstep, voffA); PG8_STAGE(PG8_SB(1, 1), cB + hsB + kstep, voffB);
    PG8_WAIT_V(6); PG8_BAR;
    for (;;) {
        const bool has_next = S.next(ui + 1, nxt);
        const char* nA = has_next ? (const char*)g.A + ((size_t)nxt.pm * BM * g.lda + nxt.acol) * 2 : cA; const char* nB = has_next ? (const char*)g.Bt + ((size_t)nxt.pn * BM * g.ldb + nxt.bcol) * 2 : cB;
#pragma nounroll
        for (int t = 0; t < nt; t += 2) {
            const bool last = (t == nt - 2);
            const char* a1 = cA + (size_t)(t + 1) * kstep;
            const char* a2 = last ? nA : cA + (size_t)(t + 2) * kstep; const char* b2 = last ? nB : cB + (size_t)(t + 2) * kstep;
            const char* a3 = a2 + kstep; const char* b3 = b2 + kstep;
            PG8_LDB(B0, 0, 0); PG8_LDB(B1, 0, 1); PG8_SCHED; PG8_LDA(At, 0, 0); PG8_STAGE(PG8_SA(1, 1), a1 + hsA, voffA);
            PG8_WAIT_V(8); PG8_WAIT_L(0); PG8_BAR; PG8_MMA(0, 0, At, B0); PG8_MMA(0, 1, At, B1); PG8_BAR; PG8_SCHED;
            PG8_LDA(At, 0, 1); PG8_STAGE(PG8_SB(0, 0), b2, voffB); PG8_STAGE(PG8_SB(0, 1), b2 + hsB, voffB); PG8_STAGE(PG8_SA(0, 0), a2, voffA);
            PG8_WAIT_V(8); PG8_WAIT_L(0); PG8_BAR; PG8_MMA(1, 0, At, B0); PG8_MMA(1, 1, At, B1); PG8_BAR; PG8_SCHED;
            PG8_LDB(B0, 1, 0); PG8_LDB(B1, 1, 1); PG8_SCHED; PG8_LDA(At, 1, 0); PG8_STAGE(PG8_SA(0, 1), a2 + hsA, voffA);
            PG8_WAIT_V(8); PG8_WAIT_L(0); PG8_BAR; PG8_MMA(0, 0, At, B0); PG8_MMA(0, 1, At, B1); PG8_BAR; PG8_SCHED;
            PG8_LDA(At, 1, 1); PG8_STAGE(PG8_SB(1, 0), b3, voffB); PG8_STAGE(PG8_SB(1, 1), b3 + hsB, voffB); PG8_STAGE(PG8_SA(1, 0), a3, voffA);
            PG8_WAIT_V(8); PG8_WAIT_L(0); PG8_BAR; PG8_MMA(1, 0, At, B0); PG8_MMA(1, 1, At, B1); PG8_BAR; PG8_SCHED;
        }
        if constexpr (ALIGN_EPI) { if (wr == 0) PG8_BAR; }
        if constexpr (!Epi::AFTER_DRAIN) E(acc, cur, wr, wc, fr, fq);
        if (!has_next) break;
        if (!cur.keep) {
#pragma unroll
            for (int a = 0; a < 2; ++a)
#pragma unroll
                for (int b = 0; b < 2; ++b)
#pragma unroll
                    for (int m = 0; m < 4; ++m)
#pragma unroll
                        for (int n = 0; n < 2; ++n) acc[a][b][m][n] = (f32x4){0.f, 0.f, 0.f, 0.f};
            if constexpr (Epi::PRELOAD) E.init(acc, nxt, wr, wc, fr, fq);
        }
        cur = nxt; cA = nA; cB = nB; ++ui;
        if constexpr (ALIGN_EPI) { if (wr == 1) PG8_BAR; }
    }
    PG8_WAIT_V(0);
    if constexpr (!ALIGN_EPI) { if (wr == 0) PG8_BAR; }
    PG8_BAR;
    if constexpr (Epi::AFTER_DRAIN) E.after(acc, cur, wr, wc, fr, fq, lds, wid, lane);
#undef PG8_SA
#undef PG8_SB
#undef PG8_STAGE
#undef PG8_LDA
#undef PG8_LDB
#undef PG8_MMA
#undef PG8_WAIT_V
#undef PG8_WAIT_L
#undef PG8_BAR
#undef PG8_SCHED
}

struct EpiProj {
    static constexpr bool AFTER_DRAIN = false;
    static constexpr bool PRELOAD = false;
    static constexpr bool PERM = true;
    bf16_t* O; bf16_t* QKV; const float* bg; bf16_t* ZPF; bf16_t* GF;
    __device__ __forceinline__ void operator()(f32x4 (&acc)[2][2][4][2], const Unit& u, int wr, int wc, int fr, int fq) const {
        const int row0 = u.pm * BM + wr * 64 + fr;
        if (u.pn < 36) {
            const int w = u.pn / 12, pr = u.pn - w * 12, g = pr >> 2, dsh = 2 * g;
#pragma unroll
            for (int ai = 0; ai < 2; ++ai)
#pragma unroll
                for (int m = 0; m < 4; ++m) { const int row = row0 + ai * HALF + m * 16, b = row >> 12, t = row & (SEQ - 1);
                    const int ridx = ((t & ((1 << dsh) - 1)) << (12 - dsh)) + (t >> dsh);
#pragma unroll
                    for (int bj = 0; bj < 2; ++bj) { const int h = (pr & 3) * 2 + bj;
                        bf16_t* dst = QKV + ((size_t)((w * 2 + b) * 3 + g) * 8 + h) * HSZ + qkv_off(ridx, wc * 4 + fq);
                        const f32x4 v0 = acc[ai][bj][m][0], v1 = acc[ai][bj][m][1];
                        u32x4 wv; wv.x = cvt_pk_bf16(v0[0], v0[1]); wv.y = cvt_pk_bf16(v0[2], v0[3]); wv.z = cvt_pk_bf16(v1[0], v1[1]); wv.w = cvt_pk_bf16(v1[2], v1[3]);
                        *(u32x4*)dst = wv; } }
            return;
        }
        const int col0 = (u.pn - 36) * BM + wc * 32 + 8 * fq;
        const int mode = (u.pn >= 48) ? 2 : (((u.pn >= 36 && u.pn < 40) || (u.pn >= 44)) ? 1 : 0);
        bf16_t* fbase = (u.pn >= 48) ? GF + frag_off(u.pm * 16 + (u.pn - 48), 0, 0, 0) : ZPF + frag_off(u.pm * 4 + (u.pn - 44), 0, 0, 0);
        const int bjs = (u.pn >= 44) ? 4096 : HALF;
        f32x4 bv[2][2];
#pragma unroll
        for (int bj = 0; bj < 2; ++bj)
#pragma unroll
            for (int n = 0; n < 2; ++n) bv[bj][n] = (mode == 2) ? *(const f32x4*)(bg + (u.pn - 48) * BM + wc * 32 + 8 * fq + bj * HALF + 4 * n) : (f32x4){0.f, 0.f, 0.f, 0.f};
#pragma unroll
        for (int ai = 0; ai < 2; ++ai)
#pragma unroll
            for (int m = 0; m < 4; ++m) { bf16_t* rowp;
                if (u.pn >= 44) rowp = fbase + frag_off(0, ai * 8 + m * 2, wr * 4 + wc, fq * 16 + fr); else rowp = O + (size_t)(row0 + ai * HALF + m * 16) * LDP + col0;
#pragma unroll
                for (int bj = 0; bj < 2; ++bj) { f32x4 v0 = acc[ai][bj][m][0] + bv[bj][0], v1 = acc[ai][bj][m][1] + bv[bj][1];
                    if (mode == 1) {
#pragma unroll
                        for (int e = 0; e < 4; ++e) { v0[e] = v0[e] * fast_sigmoid(v0[e]); v1[e] = v1[e] * fast_sigmoid(v1[e]); }
                    } else if (mode == 2) {
#pragma unroll
                        for (int e = 0; e < 4; ++e) { v0[e] = fast_sigmoid(v0[e]); v1[e] = fast_sigmoid(v1[e]); }
                    }
                    u32x4 w; w.x = cvt_pk_bf16(v0[0], v0[1]); w.y = cvt_pk_bf16(v0[2], v0[3]); w.z = cvt_pk_bf16(v1[0], v1[1]); w.w = cvt_pk_bf16(v1[2], v1[3]);
                    *(u32x4*)(rowp + bj * bjs) = w; } }
    }
};
struct EpiPool {
    static constexpr bool AFTER_DRAIN = false;
    static constexpr bool PRELOAD = false;
    static constexpr bool PERM = true;
    bf16_t* O; const bf16_t* proj; const float* ps;
    __device__ __forceinline__ void operator()(f32x4 (&acc)[2][2][4][2], const Unit& u, int wr, int wc, int fr, int fq) const {
        const int row0 = u.pm * BM + wr * 64 + fr, col0 = u.pn * BM + wc * 32 + 8 * fq;
        f32x4 sv[2][2];
#pragma unroll
        for (int bj = 0; bj < 2; ++bj)
#pragma unroll
            for (int n = 0; n < 2; ++n) sv[bj][n] = *(const f32x4*)(ps + col0 + bj * HALF + 4 * n);
#pragma unroll
        for (int ai = 0; ai < 2; ++ai)
#pragma unroll
            for (int m = 0; m < 4; ++m) { const size_t row = (size_t)(row0 + ai * HALF + m * 16);
#pragma unroll
                for (int bj = 0; bj < 2; ++bj) { const u32x4 z = *(const u32x4*)(proj + frag_off(u.pm * 4 + u.pn, ai * 8 + m * 2 + bj, wr * 4 + wc, fq * 16 + fr)); float zf[8]; unpack8(z, zf);
                    const f32x4 v0 = acc[ai][bj][m][0] * sv[bj][0], v1 = acc[ai][bj][m][1] * sv[bj][1];
                    u32x4 w; w.x = cvt_pk_bf16(v0[0] * zf[0], v0[1] * zf[1]); w.y = cvt_pk_bf16(v0[2] * zf[2], v0[3] * zf[3]); w.z = cvt_pk_bf16(v1[0] * zf[4], v1[1] * zf[5]); w.w = cvt_pk_bf16(v1[2] * zf[6], v1[3] * zf[7]);
                    *(u32x4*)(O + row * 2048 + 1024 + col0 + bj * HALF) = w; } }
    }
};
struct EpiGate {
    static constexpr bool AFTER_DRAIN = false;
    static constexpr bool PRELOAD = false;
    static constexpr bool PERM = true;
    bf16_t* O; const bf16_t* proj;
    __device__ __forceinline__ void operator()(f32x4 (&acc)[2][2][4][2], const Unit& u, int wr, int wc, int fr, int fq) const {
        asm volatile("" : "+v"(fr), "+v"(fq));
        const int row0 = u.pm * BM + wr * 64 + fr, col0 = u.pn * BM + wc * 32 + 8 * fq;
#pragma unroll
        for (int ai = 0; ai < 2; ++ai)
#pragma unroll
            for (int m = 0; m < 4; ++m) { const size_t row = (size_t)(row0 + ai * HALF + m * 16);
#pragma unroll
                for (int bj = 0; bj < 2; ++bj) { const u32x4 gp = *(const u32x4*)(proj + frag_off(u.pm * 16 + 8 + u.pn, ai * 8 + m * 2 + bj, wr * 4 + wc, fq * 16 + fr)); float gpf[8]; unpack8(gp, gpf);
#pragma unroll
                    for (int e = 0; e < 8; ++e) gpf[e] = fmaxf(gpf[e], 1e-4f);
                    if (u.tag == 0) { const u32x4 ga = *(const u32x4*)(proj + frag_off(u.pm * 16 + u.pn, ai * 8 + m * 2 + bj, wr * 4 + wc, fq * 16 + fr)); float gaf[8]; unpack8(ga, gaf);
#pragma unroll
                        for (int e = 0; e < 4; ++e) { acc[ai][bj][m][0][e] *= gaf[e] * __builtin_amdgcn_rcpf(gpf[e]); acc[ai][bj][m][1][e] *= gaf[4 + e] * __builtin_amdgcn_rcpf(gpf[4 + e]); }
                    } else { const f32x4 v0 = acc[ai][bj][m][0], v1 = acc[ai][bj][m][1];
                        u32x4 w; w.x = cvt_pk_bf16(v0[0] * gpf[0], v0[1] * gpf[1]); w.y = cvt_pk_bf16(v0[2] * gpf[2], v0[3] * gpf[3]); w.z = cvt_pk_bf16(v1[0] * gpf[4], v1[1] * gpf[5]); w.w = cvt_pk_bf16(v1[2] * gpf[6], v1[3] * gpf[7]);
                        *(u32x4*)(O + row * 2048 + col0 + bj * HALF) = w; } } }
    }
};
struct EpiRes {
    static constexpr bool PERM = false, PRELOAD = true;
    const float* x; float* out;
    __device__ __forceinline__ void init(f32x4 (&acc)[2][2][4][2], const Unit& u, int wr, int wc, int fr, int fq) const {
        const int row0 = u.pm * BM + wr * 64 + fr, col0 = u.pn * BM + wc * 32 + 4 * fq;
#pragma unroll
        for (int ai = 0; ai < 2; ++ai)
#pragma unroll
            for (int m = 0; m < 4; ++m) { const size_t off = (size_t)(row0 + ai * HALF + m * 16) * DM + col0;
#pragma unroll
                for (int bj = 0; bj < 2; ++bj)
#pragma unroll
                    for (int n = 0; n < 2; ++n) acc[ai][bj][m][n] = __builtin_nontemporal_load((const f32x4*)(x + off + bj * HALF + n * 16)); }
    }
    static constexpr bool AFTER_DRAIN = true;
    __device__ __forceinline__ void after(f32x4 (&acc)[2][2][4][2], const Unit& u, int wr, int wc, int fr, int fq, LAS unsigned char* lds, int wid, int lane) const {
        constexpr int RP = 1040;
        asm volatile("" : "+v"(lane), "+v"(fr));
#pragma unroll
        for (int ai = 0; ai < 2; ++ai) {
#pragma unroll
            for (int m = 0; m < 4; ++m)
#pragma unroll
                for (int bj = 0; bj < 2; ++bj)
#pragma unroll
                    for (int n = 0; n < 2; ++n) *(LAS f32x4*)(lds + (wr * 64 + m * 16 + fr) * RP + (bj * HALF + wc * 32 + n * 16 + 4 * fq) * 4) = acc[ai][bj][m][n];
            asm volatile("s_waitcnt lgkmcnt(0)\n\ts_barrier" ::: "memory");
            float* orow = out + (size_t)(u.pm * BM + ai * HALF + wid * 16) * DM + u.pn * BM + 4 * lane;
#pragma unroll 4
            for (int r = 0; r < 16; ++r) { const f32x4 v = *(const LAS f32x4*)(lds + (wid * 16 + r) * RP + lane * 16); __builtin_nontemporal_store(v, (f32x4*)(orow + (size_t)r * DM)); }
            asm volatile("s_waitcnt lgkmcnt(0)\n\ts_barrier" ::: "memory");
        }
    }
};
}

constexpr int KROW = 288;
constexpr int ATT_K_OFF = 0;
constexpr int ATT_V_OFF = 256 * KROW;
constexpr int ATT_RS_OFF = ATT_V_OFF + 272 * KROW;
constexpr int ATT_G_OFF = ATT_RS_OFF + 512;
constexpr int N_ATT_UNITS = 3 * BATCH * 8 * 32;
static_assert(ATT_G_OFF + 1024 <= LDS_BYTES - 64, "attention LDS map");

__device__ __forceinline__ float dpp_f(float v, const int ctrl_dummy) { return v; }
#define DPP_ADD(v, ctrl) ((v) + __builtin_bit_cast(float, __builtin_amdgcn_update_dpp(0, __builtin_bit_cast(int, (v)), (ctrl), 0xF, 0xF, true)))

#define LDS_BARRIER() asm volatile("s_waitcnt lgkmcnt(0)\n\ts_barrier" ::: "memory")
struct AttnU { int g, b, h, r, blk, dsh; };
__device__ __forceinline__ AttnU attn_decode(int u) {
    AttnU U; U.g = u >> 9; const int rem = u & 511; U.b = rem >> 8; U.h = (rem >> 5) & 7; const int sub = rem & 31;
    U.dsh = 2 * U.g; const int nbsh = 5 - U.dsh; U.r = sub >> nbsh; U.blk = sub & ((1 << nbsh) - 1); return U;
}
__device__ __forceinline__ const bf16_t* attn_kslab(const bf16_t* qkv, const AttnU& U) { return qkv + ((size_t)((1 * 2 + U.b) * 3 + U.g) * 8 + U.h) * HSZ; }

struct AttnRegs { u32x4 rawk[4], rawv[4], rk2lo, rk2hi, rawq[4]; f32x4 kc0, kc1, ksn0, ksn1, qc0, qc1, qs0, qs1; };
__device__ __forceinline__ void attn_issue_kv(const bf16_t* __restrict__ qkv, const AttnU& U, int blkidx, AttnRegs& R) {
    const int tid = threadIdx.x, chunk = tid & 15, rowi = tid >> 4;
    const bf16_t* base = attn_kslab(qkv, U) + (size_t)((U.r << (12 - U.dsh)) + blkidx * 128) * HD;
#pragma unroll
    for (int p = 0; p < 4; ++p) { const bf16_t* rp = base + qkv_off(p * 32 + rowi, chunk); R.rawk[p] = *(const u32x4*)rp; R.rawv[p] = *(const u32x4*)(rp + 6 * 8 * HSZ); }
}
__device__ __forceinline__ void attn_issue_aux(const bf16_t* __restrict__ qkv, const float* __restrict__ ropec, const float* __restrict__ ropes, const AttnU& U, int blkidx, AttnRegs& R, bool withq) {
    const int tid = threadIdx.x;
    const bf16_t* base = attn_kslab(qkv, U) + (size_t)((U.r << (12 - U.dsh)) + blkidx * 128) * HD;
    const bf16_t* rp2 = base + qkv_off(tid >> 2, (tid >> 1) & 1);
    R.rk2lo = *(const u32x4*)rp2; R.rk2hi = *(const u32x4*)(rp2 + 16);
    const int t2 = (((blkidx * 128 + (tid >> 2)) << U.dsh) + U.r) * 16 + ((tid >> 1) & 1) * 8;
    R.kc0 = *(const f32x4*)(ropec + t2); R.kc1 = *(const f32x4*)(ropec + t2 + 4); R.ksn0 = *(const f32x4*)(ropes + t2); R.ksn1 = *(const f32x4*)(ropes + t2 + 4);
    if (withq) {
        const int lane = tid & 63, fr = lane & 15, fq = lane >> 4, iq = 16 * (tid >> 6) + fr;
        const bf16_t* qp = attn_kslab(qkv, U) - 6 * 8 * HSZ + (size_t)((U.r << (12 - U.dsh)) + U.blk * 128) * HD + qkv_off(iq, fq);
#pragma unroll
        for (int ks = 0; ks < 4; ++ks) R.rawq[ks] = *(const u32x4*)(qp + ks * 512);
        const int tq = ((((U.blk * 128) + iq) << U.dsh) + U.r) * 16 + (fq & 1) * 8;
        R.qc0 = *(const f32x4*)(ropec + tq); R.qc1 = *(const f32x4*)(ropec + tq + 4); R.qs0 = *(const f32x4*)(ropes + tq); R.qs1 = *(const f32x4*)(ropes + tq + 4);
    }
}
__device__ __forceinline__ void attn_fill(LAS unsigned char* lds, int slot, const AttnRegs& R, const float* __restrict__ kg) {
    const int tid = threadIdx.x, chunk = tid & 15, rowi = tid >> 4;
    LAS float* rsl = (LAS float*)(lds + ATT_RS_OFF);
    float kgain[8];
    { const f32x4 g0 = *(const LAS f32x4*)(lds + ATT_G_OFF + 512 + chunk * 32), g1 = *(const LAS f32x4*)(lds + ATT_G_OFF + 512 + chunk * 32 + 16);
#pragma unroll
      for (int e = 0; e < 4; ++e) { kgain[e] = g0[e]; kgain[4 + e] = g1[e]; } }
#pragma unroll
    for (int p = 0; p < 4; ++p) {
        const int j = p * 32 + rowi;
        float v[8]; unpack8(R.rawk[p], v);
        float ss = 0.f;
#pragma unroll
        for (int e = 0; e < 8; ++e) ss += v[e] * v[e];
        ss = DPP_ADD(ss, 0xB1); ss = DPP_ADD(ss, 0x4E); ss = DPP_ADD(ss, 0x124); ss = DPP_ADD(ss, 0x128);
        const float rs = rsqrtf(ss * (1.0f / 128.0f) + NORM_EPS);
#pragma unroll
        for (int e = 0; e < 8; ++e) v[e] = v[e] * rs * kgain[e];
        if (chunk == 0) rsl[j] = rs;
        *(LAS u32x4*)(lds + ATT_K_OFF + (slot * 128 + j) * KROW + chunk * 16) = pack8(v);
        *(LAS u32x4*)(lds + ATT_V_OFF + (slot * 128 + j) * KROW + chunk * 16) = R.rawv[p];
    }
}
__device__ __forceinline__ void attn_rope(LAS unsigned char* lds, int slot, const AttnRegs& R, const float* __restrict__ kg) {
    const int tid = threadIdx.x; const f32x4 kc0 = R.kc0, kc1 = R.kc1, ksn0 = R.ksn0, ksn1 = R.ksn1;
    {
        const int j2 = tid >> 2, pr = (tid >> 1) & 1, part = tid & 1;
        const float rs = ((LAS float*)(lds + ATT_RS_OFF))[j2];
        float lo[8], hi[8], o[8]; unpack8(R.rk2lo, lo); unpack8(R.rk2hi, hi);
        const float sg = part ? 1.f : -1.f;
#pragma unroll
        for (int e = 0; e < 8; ++e) { const float l = lo[e] * rs * ((const LAS float*)(lds + ATT_G_OFF + 512))[pr * 8 + e], h = hi[e] * rs * ((const LAS float*)(lds + ATT_G_OFF + 512))[16 + pr * 8 + e];
            lo[e] = part ? h : l; hi[e] = part ? l : h; }
#pragma unroll
        for (int e = 0; e < 4; ++e) { o[e] = lo[e] * kc0[e] + sg * hi[e] * ksn0[e]; o[4 + e] = lo[4 + e] * kc1[e] + sg * hi[4 + e] * ksn1[e]; }
        *(LAS u32x4*)(lds + ATT_K_OFF + (slot * 128 + j2) * KROW + (pr + 2 * part) * 16) = pack8(o);
    }
}
__device__ __forceinline__ void attn_phase(LAS unsigned char* lds, const bf16_t* __restrict__ qkv, const float* __restrict__ ropec, const float* __restrict__ ropes,
                                           const float* __restrict__ qg, const float* __restrict__ kg, bf16_t* __restrict__ O, float* __restrict__ lse, int u0, int nu, int flags) {
    const int tid = threadIdx.x, wid = __builtin_amdgcn_readfirstlane(tid >> 6), lane = tid & 63, fr = lane & 15, fq = lane >> 4;
    if (nu <= 0) return;
    for (int o = tid * 16; o < 272 * KROW; o += NTHREADS * 16) *(LAS u32x4*)(lds + ATT_V_OFF + o) = (u32x4){0u, 0u, 0u, 0u};
    for (int o = tid * 16; o < 256 * KROW; o += NTHREADS * 16) *(LAS u32x4*)(lds + ATT_K_OFF + o) = (u32x4){0u, 0u, 0u, 0u};
    if (tid < 128) ((LAS float*)(lds + ATT_G_OFF))[tid] = qg[tid]; else if (tid < 256) ((LAS float*)(lds + ATT_G_OFF))[tid] = kg[tid - 128];
    __syncthreads();
    int P = 0;
    AttnRegs R;
    {
        const AttnU U0 = attn_decode(u0);
        if (U0.blk > 0) {
            AttnRegs Rp;
            attn_issue_kv(qkv, U0, U0.blk - 1, Rp); attn_issue_aux(qkv, ropec, ropes, U0, U0.blk - 1, Rp, false);
            attn_issue_kv(qkv, U0, U0.blk, R); attn_issue_aux(qkv, ropec, ropes, U0, U0.blk, R, true);
            attn_fill(lds, P, Rp, kg);
            __syncthreads();
            attn_rope(lds, P, Rp, kg);
            __syncthreads();
        } else { attn_issue_kv(qkv, U0, U0.blk, R); attn_issue_aux(qkv, ropec, ropes, U0, U0.blk, R, true); }
    }
    for (int i = 0; i < nu; ++i) {
        const AttnU U = attn_decode(u0 + i);
        const int C = 1 - P;
        const int iq = 16 * wid + fr;
        const int tq = (((U.blk * 128) + iq) << U.dsh) + U.r;
        const size_t growq = (size_t)(U.b * SEQ + tq);
        const size_t hcol = (size_t)U.g * 1024 + U.h * 128;
        u32x4 rawq[4];
#pragma unroll
        for (int ks = 0; ks < 4; ++ks) rawq[ks] = R.rawq[ks];
        const f32x4 qc0 = R.qc0, qc1 = R.qc1, qs0 = R.qs0, qs1 = R.qs1;
        attn_fill(lds, C, R, kg);
        const bool more = (i + 1 < nu);
        const AttnU Un = attn_decode(u0 + (more ? i + 1 : i));
        attn_issue_kv(qkv, Un, Un.blk, R);
        LDS_BARRIER();
        attn_rope(lds, C, R, kg);
        bf16x8 qf[4];
        {
            float v[4][8]; float ss = 0.f;
#pragma unroll
            for (int ks = 0; ks < 4; ++ks) { unpack8(rawq[ks], v[ks]);
#pragma unroll
                for (int e = 0; e < 8; ++e) ss += v[ks][e] * v[ks][e]; }
            ss += __shfl_xor(ss, 16); ss += __shfl_xor(ss, 32);
            const float rs = rsqrtf(ss * (1.0f / 128.0f) + NORM_EPS);
#pragma unroll
            for (int ks = 0; ks < 4; ++ks)
#pragma unroll
                for (int e = 0; e < 8; ++e) v[ks][e] = v[ks][e] * rs * ((const LAS float*)(lds + ATT_G_OFF))[ks * 32 + fq * 8 + e];
            {
                float ot[8];
#pragma unroll
                for (int e = 0; e < 8; ++e) ot[e] = __shfl_xor(v[0][e], 32);
                const float sg = (fq < 2) ? -1.f : 1.f;
#pragma unroll
                for (int e = 0; e < 4; ++e) { v[0][e] = v[0][e] * qc0[e] + sg * ot[e] * qs0[e]; v[0][4 + e] = v[0][4 + e] * qc1[e] + sg * ot[4 + e] * qs1[e]; }
            }
#pragma unroll
            for (int ks = 0; ks < 4; ++ks) qf[ks] = __builtin_bit_cast(bf16x8, pack8(v[ks]));
        }
        attn_issue_aux(qkv, ropec, ropes, Un, Un.blk, R, true);
        LDS_BARRIER();
        f32x4 sacc[9];
#pragma unroll
        for (int t = 0; t < 9; ++t) {
            const int ta = wid + t; const int krow = (ta < 8) ? (P * 128 + 16 * ta) : (C * 128 + 16 * (ta - 8));
            sacc[t] = (f32x4){0.f, 0.f, 0.f, 0.f};
#pragma unroll
            for (int ks = 0; ks < 4; ++ks) { const bf16x8 a = *(const LAS bf16x8*)(lds + ATT_K_OFF + (krow + fr) * KROW + (ks * 32 + fq * 8) * 2);
                sacc[t] = __builtin_amdgcn_mfma_f32_16x16x32_bf16(a, qf[ks], sacc[t], 0, 0, 0); }
        }
        const float c2 = 0.08838834764831845f * 1.4426950408889634f;
        float mx = -INFINITY;
#pragma unroll
        for (int t = 0; t < 9; ++t) {
            const bool dead = (U.blk == 0) && (wid + t < 8);
#pragma unroll
            for (int i2 = 0; i2 < 4; ++i2) {
                bool valid = !dead;
                if (t == 0) valid = valid && (4 * fq + i2 >= fr);
                if (t == 8) valid = valid && (4 * fq + i2 <= fr);
                const float sv = valid ? sacc[t][i2] * c2 : -INFINITY; sacc[t][i2] = sv; mx = fmaxf(mx, sv); }
        }
        mx = fmaxf(mx, __shfl_xor(mx, 16)); mx = fmaxf(mx, __shfl_xor(mx, 32));
        float sum = 0.f;
#pragma unroll
        for (int t = 0; t < 9; ++t)
#pragma unroll
            for (int i2 = 0; i2 < 4; ++i2) { const float pv = __builtin_amdgcn_exp2f(sacc[t][i2] - mx); sacc[t][i2] = pv; sum += pv; }
        sum += __shfl_xor(sum, 16); sum += __shfl_xor(sum, 32);
        bf16x8 pf[5];
#pragma unroll
        for (int s2 = 0; s2 < 4; ++s2) { u32x4 w; w.x = cvt_pk_bf16(sacc[2 * s2][0], sacc[2 * s2][1]); w.y = cvt_pk_bf16(sacc[2 * s2][2], sacc[2 * s2][3]);
            w.z = cvt_pk_bf16(sacc[2 * s2 + 1][0], sacc[2 * s2 + 1][1]); w.w = cvt_pk_bf16(sacc[2 * s2 + 1][2], sacc[2 * s2 + 1][3]); pf[s2] = __builtin_bit_cast(bf16x8, w); }
        { u32x4 w; w.x = cvt_pk_bf16(sacc[8][0], sacc[8][1]); w.y = cvt_pk_bf16(sacc[8][2], sacc[8][3]); w.z = 0u; w.w = 0u; pf[4] = __builtin_bit_cast(bf16x8, w); }
        f32x4 o[8];
#pragma unroll
        for (int dt = 0; dt < 8; ++dt) o[dt] = (f32x4){0.f, 0.f, 0.f, 0.f};
#pragma unroll
        for (int s2 = 0; s2 < 5; ++s2) {
            const int ta = wid + 2 * s2, tb = ta + 1;
            const int rowa = (ta < 8) ? (P * 128 + 16 * ta) : (C * 128 + 16 * (ta - 8));
            const int rowb = (tb < 8) ? (P * 128 + 16 * tb) : ((tb < 16) ? (C * 128 + 16 * (tb - 8)) : 256);
            const LAS unsigned char* pa = lds + ATT_V_OFF + (rowa + 4 * fq + (fr >> 2)) * KROW + (4 * (fr & 3)) * 2;
            const LAS unsigned char* pb = lds + ATT_V_OFF + (rowb + 4 * fq + (fr >> 2)) * KROW + (4 * (fr & 3)) * 2;
#pragma unroll
            for (int dt = 0; dt < 8; ++dt) {
                const v4i16_t lo = __builtin_amdgcn_ds_read_tr16_b64_v4i16((LAS v4i16_t*)(pa + dt * 32));
                const v4i16_t hi = __builtin_amdgcn_ds_read_tr16_b64_v4i16((LAS v4i16_t*)(pb + dt * 32));
                const bf16x8 a = __builtin_shufflevector(lo, hi, 0, 1, 2, 3, 4, 5, 6, 7);
                o[dt] = __builtin_amdgcn_mfma_f32_16x16x32_bf16(a, pf[s2], o[dt], 0, 0, 0);
            }
        }
        const float inv = 1.0f / sum;
        bf16_t* op = O + growq * 3072 + hcol + 4 * fq;
#pragma unroll
        for (int k2 = 0; k2 < 4; ++k2) {
            u32x2 we, wo; we.x = cvt_pk_bf16(o[2 * k2][0] * inv, o[2 * k2][1] * inv); we.y = cvt_pk_bf16(o[2 * k2][2] * inv, o[2 * k2][3] * inv);
            wo.x = cvt_pk_bf16(o[2 * k2 + 1][0] * inv, o[2 * k2 + 1][1] * inv); wo.y = cvt_pk_bf16(o[2 * k2 + 1][2] * inv, o[2 * k2 + 1][3] * inv);
            const bool odd = fq & 1;
            u32x2 snd = odd ? we : wo, rcv; rcv.x = __shfl_xor(snd.x, 16); rcv.y = __shfl_xor(snd.y, 16);
            u32x4 w; if (odd) { w.x = rcv.x; w.y = rcv.y; w.z = wo.x; w.w = wo.y; } else { w.x = we.x; w.y = we.y; w.z = rcv.x; w.w = rcv.y; }
            *(u32x4*)(O + growq * 3072 + hcol + (2 * k2 + (odd ? 1 : 0)) * 16 + 4 * (fq & 2)) = w; }
        if (fq == 0) lse[growq * 24 + U.g * 8 + U.h] = (mx + __log2f(sum)) * 0.6931471805599453f;
        LDS_BARRIER();
        P = C;
    }
}

#define XB_TMO      128
#define XB_XCNT(j)  (256  + 64 * (j))
#define XB_XSUB(j)  (1280 + 64 * (j))
#define XB_XGEN(j)  (2304 + 64 * (j))
#define XB_TOP      3328
#define XB_TOPGEN   3392
#define XCD_BAR_WORDS 3456
#define XB_SPIN_CAP (1u << 22)
__device__ __forceinline__ unsigned xb_ld(unsigned* p)              { return __hip_atomic_load(p, __ATOMIC_RELAXED, __HIP_MEMORY_SCOPE_AGENT); }
__device__ __forceinline__ unsigned xb_add(unsigned* p, unsigned v) { return __hip_atomic_fetch_add(p, v, __ATOMIC_RELAXED, __HIP_MEMORY_SCOPE_AGENT); }
__device__ __forceinline__ unsigned xb_xcc_id() { return (unsigned)__builtin_amdgcn_s_getreg((3 << 11) | 20) & 0xFu; }
#define XB_SPIN(cond, bar) do { unsigned _sp = 0; while (cond) { __builtin_amdgcn_s_sleep(1); \
    if ((++_sp & 255u) == 0u) { if (xb_ld(&(bar)[XB_TMO])) break; if (_sp > XB_SPIN_CAP) { atomicAdd(&(bar)[XB_TMO], 1u); break; } } } } while (0)
struct XcdBarrier { unsigned* bar; unsigned x; volatile LAS unsigned* st; };
__device__ __forceinline__ XcdBarrier xcd_barrier_post(unsigned* bar, volatile LAS unsigned* st) {
    XcdBarrier b; b.bar = bar; b.x = xb_xcc_id(); b.st = st;
    if (threadIdx.x == 0) (void)xb_add(&bar[XB_XCNT(b.x)], 1u);
    return b;
}
__device__ __forceinline__ void xcd_barrier_complete(unsigned* bar, unsigned x, unsigned& nloc, unsigned& nx) {
    const unsigned G = gridDim.x * gridDim.y * gridDim.z;
    unsigned sum, cnt, mine, sp = 0u;
    for (;;) {
        sum = 0u; cnt = 0u; mine = 0u;
#pragma unroll
        for (unsigned j = 0; j < 16; ++j) { const unsigned c = xb_ld(&bar[XB_XCNT(j)]); sum += c; cnt += (c > 0u) ? 1u : 0u; mine = (j == x) ? c : mine; }
        if (sum == G) break;
        __builtin_amdgcn_s_sleep(1);
        if ((++sp & 255u) == 0u) { if (xb_ld(&bar[XB_TMO])) break; if (sp > XB_SPIN_CAP) { atomicAdd(&bar[XB_TMO], 1u); break; } }
    }
    nloc = mine > 0u ? mine : 1u; nx = cnt > 0u ? cnt : 1u;
}
__device__ __forceinline__ void xcd_barrier(const XcdBarrier& b) {
    asm volatile("s_waitcnt vmcnt(0)" ::: "memory");
    __syncthreads();
    if (threadIdx.x == 0) {
        unsigned* bar = b.bar;
        __builtin_amdgcn_s_waitcnt(0);
        unsigned nloc = b.st[0], nx = b.st[1];
        if (nloc == 0u) { xcd_barrier_complete(bar, b.x, nloc, nx); b.st[0] = nloc; b.st[1] = nx; }
        const unsigned old = xb_add(&bar[XB_XSUB(b.x)], 1u);
        const unsigned gen = old / nloc;
        if (old + 1u == (gen + 1u) * nloc) {
            __builtin_amdgcn_fence(__ATOMIC_RELEASE, "agent");
            asm volatile("s_waitcnt vmcnt(0)" ::: "memory");
            const unsigned og = xb_add(&bar[XB_TOP], 1u);
            const unsigned tg = og / nx;
            if (og + 1u == (tg + 1u) * nx) xb_add(&bar[XB_TOPGEN], 1u);
            else XB_SPIN(xb_ld(&bar[XB_TOPGEN]) == tg, bar);
            __builtin_amdgcn_fence(__ATOMIC_ACQUIRE, "agent");
            xb_add(&bar[XB_XGEN(b.x)], 1u);
            asm volatile("s_waitcnt vmcnt(0)" ::: "memory");
        } else {
            XB_SPIN(xb_ld(&bar[XB_XGEN(b.x)]) == gen, bar);
            __builtin_amdgcn_fence(__ATOMIC_ACQUIRE, "agent");
            asm volatile("s_waitcnt vmcnt(0)" ::: "memory");
        }
    }
    __syncthreads();
}

template <int KSZ> __device__ __forceinline__ void pool_diff_run(const bf16_t* __restrict__ PROJ, bf16_t* __restrict__ DB, int row0, int ch) {
    const int s0 = row0 & (SEQ - 1);
    const bf16_t* up = PROJ + (size_t)row0 * LDP + C_U + ch * 8;
    u32x4 raw[KSZ + 7];
#pragma unroll
    for (int i = 0; i < KSZ + 7; ++i) { const int d = (KSZ - 1) - i;
        raw[i] = (d <= s0) ? *(const u32x4*)(up - (ptrdiff_t)d * LDP) : (u32x4){0u, 0u, 0u, 0u}; }
    float W[8];
#pragma unroll
    for (int e = 0; e < 8; ++e) W[e] = 0.f;
#pragma unroll
    for (int i = 0; i < KSZ - 1; ++i) { float t[8]; unpack8(raw[i], t);
#pragma unroll
        for (int e = 0; e < 8; ++e) W[e] += t[e]; }
#pragma unroll
    for (int k = 0; k < 8; ++k) {
        float cur[8], old[8], o[8]; unpack8(raw[KSZ - 1 + k], cur); unpack8(raw[k], old);
        const int cnt = (s0 + k + 1 < KSZ) ? (s0 + k + 1) : KSZ; const float ic = 1.0f / (float)cnt;
#pragma unroll
        for (int e = 0; e < 8; ++e) { W[e] += cur[e]; o[e] = W[e] * ic - cur[e]; W[e] -= old[e]; }
        *(u32x4*)(DB + (size_t)(row0 + k) * 1024 + ch * 8) = pack8(o);
    }
}

template <int NQ> __device__ __forceinline__ void mix_rows(const bf16_t* __restrict__ OB, const float* __restrict__ LSE, const bf16_t* __restrict__ PROJ, bf16_t* __restrict__ A12, int rowb) {
    const int tid = threadIdx.x;
    u32x4 ra0[NQ], ra1[NQ], ra2[NQ], rz[NQ]; float l0[NQ], l1[NQ], l2[NQ];
#pragma unroll
    for (int q = 0; q < NQ; ++q) { const int it = q * NTHREADS + tid, row = rowb + (it >> 7), ch = it & 127, h = ch >> 4;
        l0[q] = LSE[(size_t)row * 24 + h]; l1[q] = LSE[(size_t)row * 24 + 8 + h]; l2[q] = LSE[(size_t)row * 24 + 16 + h];
        const bf16_t* op = OB + (size_t)row * 3072 + ch * 8;
        ra0[q] = *(const u32x4*)op; ra1[q] = *(const u32x4*)(op + 1024); ra2[q] = *(const u32x4*)(op + 2048);
        rz[q] = *(const u32x4*)(PROJ + (size_t)row * LDP + C_ZA + ch * 8); }
#pragma unroll
    for (int q = 0; q < NQ; ++q) { const int it = q * NTHREADS + tid, row = rowb + (it >> 7), ch = it & 127;
        const float mxl = fmaxf(l0[q], fmaxf(l1[q], l2[q]));
        float w0 = __expf(l0[q] - mxl), w1 = __expf(l1[q] - mxl), w2 = __expf(l2[q] - mxl); const float iw = 1.0f / (w0 + w1 + w2); w0 *= iw; w1 *= iw; w2 *= iw;
        float a0[8], a1[8], a2[8], z[8], r[8];
        unpack8(ra0[q], a0); unpack8(ra1[q], a1); unpack8(ra2[q], a2); unpack8(rz[q], z);
#pragma unroll
        for (int e = 0; e < 8; ++e) r[e] = (w0 * a0[e] + w1 * a1[e] + w2 * a2[e]) * z[e];
        *(u32x4*)(A12 + (size_t)row * 2048 + ch * 8) = pack8(r); }
}

__device__ __forceinline__ unsigned f2bf(float f) { unsigned u = __builtin_bit_cast(unsigned, f); return (u + 0x7fffu + ((u >> 16) & 1u)) >> 16; }
__device__ __forceinline__ unsigned pk2(float lo, float hi) { return f2bf(lo) | (f2bf(hi) << 16); }
__device__ __forceinline__ void transpose_item(const float* __restrict__ W, int ldw, bf16_t* __restrict__ WT, int ldt, LAS float* scr, int kb, int nb, int lane) {
    const int k0 = 64 * kb, n0 = 32 * nb;
#pragma unroll 8
    for (int i = 0; i < 32; ++i) { const int kk = 2 * i + (lane >> 5); scr[kk * 33 + (lane & 31)] = __builtin_nontemporal_load(W + (size_t)(k0 + kk) * ldw + n0 + (lane & 31)); }
    asm volatile("s_waitcnt lgkmcnt(0)" ::: "memory");
    const int c = lane & 7;
#pragma unroll
    for (int j = 0; j < 4; ++j) { const int n = (lane >> 3) + 8 * j; const LAS float* s = scr + (8 * c) * 33 + n;
        u32x4 o; o.x = pk2(s[0 * 33], s[1 * 33]); o.y = pk2(s[2 * 33], s[3 * 33]); o.z = pk2(s[4 * 33], s[5 * 33]); o.w = pk2(s[6 * 33], s[7 * 33]);
        *(u32x4*)(WT + (size_t)(n0 + n) * ldt + k0 + 8 * c) = o; }
    asm volatile("s_waitcnt lgkmcnt(0)" ::: "memory");
}

struct Args { const float* in[11]; float* out; unsigned char* ws; int ph_lo, ph_hi, flags, pad; };

__global__ void __launch_bounds__(NTHREADS, 2) fwd_kernel(Args args) {
    extern __shared__ __attribute__((aligned(16))) unsigned char lds_raw[];
    LAS unsigned char* lds = (LAS unsigned char*)lds_raw;
    const int tid = threadIdx.x, lane = tid & 63, wave = __builtin_amdgcn_readfirstlane(tid >> 6);
    const int G = gridDim.x, bx = blockIdx.x;
    const int lo = args.ph_lo, hi = args.ph_hi;
    unsigned char* ws = args.ws;
    const float* x = args.in[0]; const float* norm_gain = args.in[1]; const float* w_in = args.in[2]; const float* b_gates = args.in[3];
    const float* q_gain = args.in[4]; const float* k_gain = args.in[5]; const float* pool_maps = args.in[6]; const float* pool_scale = args.in[7];
    const float* w_ba = args.in[8]; const float* w_bp = args.in[9]; const float* w_out = args.in[10];
    bf16_t* WinT = (bf16_t*)(ws + WS_WIN); bf16_t* W12T = (bf16_t*)(ws + WS_W12); bf16_t* WoT = (bf16_t*)(ws + WS_WO); bf16_t* PMT = (bf16_t*)(ws + WS_PM);
    float* ropec = (float*)(ws + WS_ROPE); float* ropes = ropec + 4096 * 16;
    bf16_t* XN = (bf16_t*)(ws + WS_XN); bf16_t* PROJ = (bf16_t*)(ws + WS_PROJ); bf16_t* ZPF = (bf16_t*)(ws + WS_ZPF); bf16_t* GF = (bf16_t*)(ws + WS_GF); bf16_t* QKVH = (bf16_t*)(ws + WS_QKV); bf16_t* OB = (bf16_t*)(ws + WS_O); float* LSE = (float*)(ws + WS_LSE);
    bf16_t* DB = (bf16_t*)(ws + WS_D); bf16_t* A12 = (bf16_t*)(ws + WS_A12); bf16_t* MG = (bf16_t*)(ws + WS_MG);
    volatile LAS unsigned* MISC = (volatile LAS unsigned*)(lds + LDS_BYTES - 64);
    if (tid < 16) MISC[tid] = 0u;
    __syncthreads();
    XcdBarrier bar; bar.bar = (unsigned*)(ws + WS_CTL); bar.x = 0; bar.st = nullptr;
    if (hi - lo > 1) bar = xcd_barrier_post((unsigned*)(ws + WS_CTL), MISC);
#define IN(k) (lo <= (k) && (k) < hi)
#define SEAM(k) do { if (IN(k) && IN((k) + 1)) { xcd_barrier(bar); } } while (0)

    if (IN(0)) {
        LAS float* scr = (LAS float*)(lds + wave * 16384);
        const int gw = bx * NWAVES + wave, NGW = G * NWAVES;
        constexpr int I_IN = 32 * 512, I_BA = 16 * 64, I_BP = 16 * 64, I_O = 32 * 64, I_PM = 4 * 32;
        constexpr int NITEMS = I_IN + I_BA + I_BP + I_O + I_PM;
        for (int it = gw; it < NITEMS; it += NGW) {
            int r = it;
            if (r < I_IN) { transpose_item(w_in, INC, WinT, 2048, scr, r / 512, r % 512, lane); continue; } r -= I_IN;
            if (r < I_BA) { transpose_item(w_ba, 2048, W12T, 2048, scr, r / 64, r % 64, lane); continue; } r -= I_BA;
            if (r < I_BP) { transpose_item(w_bp, 2048, W12T + 1024, 2048, scr, r / 64, r % 64, lane); continue; } r -= I_BP;
            if (r < I_O) { transpose_item(w_out, 2048, WoT, 2048, scr, r / 64, r % 64, lane); continue; } r -= I_O;
            { const int gi = r >> 5, rr = r & 31; transpose_item(pool_maps + (size_t)gi * 65536, 256, PMT + (size_t)gi * 65536, 256, scr, rr >> 3, rr & 7, lane); }
        }
        for (int m = gw; m < M; m += NGW) {
            const f32x4* xr = (const f32x4*)(x + (size_t)m * DM) + lane;
            f32x4 v[8]; float s = 0.f;
#pragma unroll
            for (int j = 0; j < 8; ++j) { v[j] = __builtin_nontemporal_load(xr + 64 * j); s += (v[j].x * v[j].x + v[j].y * v[j].y) + (v[j].z * v[j].z + v[j].w * v[j].w); }
#pragma unroll
            for (int o = 1; o < 64; o <<= 1) s += __shfl_xor(s, o);
            const float rs = rsqrtf(s * (1.0f / DM) + NORM_EPS);
            u32x2* o8 = (u32x2*)(XN + (size_t)m * DM) + lane;
#pragma unroll
            for (int j = 0; j < 8; ++j) { const f32x4 gn = *((const f32x4*)norm_gain + lane + 64 * j); u32x2 w; w.x = cvt_pk_bf16(v[j].x * rs * gn.x, v[j].y * rs * gn.y); w.y = cvt_pk_bf16(v[j].z * rs * gn.z, v[j].w * rs * gn.w); o8[64 * j] = w; }
        }
        {
            const float invf[16] = {1.000000000e+00f, 4.403665960e-01f, 1.939227432e-01f, 8.539710194e-02f, 3.760603070e-02f, 1.656043902e-02f, 7.292664610e-03f, 3.211445874e-03f,
                                    1.414213562e-03f, 6.227723788e-04f, 2.742481884e-04f, 1.207697351e-04f, 5.318296098e-05f, 2.341999971e-05f, 1.031338616e-05f, 4.541670478e-06f};
            for (int idx = bx * NTHREADS + tid; idx < 4096 * 16; idx += G * NTHREADS) {
                const int pos = idx >> 4, j = idx & 15;
                float f = invf[0];
#pragma unroll
                for (int q = 1; q < 16; ++q) f = (j == q) ? invf[q] : f;
                const float ang = (float)pos * f;
                double rev = (double)ang * 0.15915494309189535; rev -= __builtin_rint(rev);
                const float rf = (float)rev;
                ropec[idx] = __builtin_amdgcn_cosf(rf); ropes[idx] = __builtin_amdgcn_sinf(rf);
            }
        }
        __syncthreads();
    }
    SEAM(0);

    if (IN(1)) {
        pg8::Gemm g{XN, WinT, 2048, 2048, 2048}; pg8::SchedStd S{M / 256, INC / 256, G, bx};
        pg8::EpiProj E{PROJ, QKVH, b_gates, ZPF, GF};
        pg8::gemm_phase<pg8::EpiProj, pg8::SchedStd, true>(lds, g, S, E);
    }
    SEAM(1);

    if (IN(2)) {
        const bool has_pool = bx < 128;
        if (has_pool && !(args.flags & 2)) {
            const int pm = bx >> 2, pg = bx & 3;
            u32x4 wm[8];
#pragma unroll
            for (int q = 0; q < 4; ++q) wm[q] = *(const u32x4*)(PMT + (size_t)pg * 65536 + (size_t)(q * NTHREADS + tid) * 32);
#pragma unroll
            for (int q = 0; q < 4; ++q) { const int it = q * NTHREADS + tid, rr = it >> 3, cc = it & 7;
                (void)rr; (void)cc; wm[4 + q] = *(const u32x4*)(ZPF + (size_t)(pm * 4 + pg) * 65536 + (size_t)it * 32); }
#pragma unroll
            for (int q = 0; q < 2; ++q) { const int it = q * NTHREADS + tid, run = it >> 5, ch = pg * 32 + (it & 31), row0 = pm * 256 + run * 8;
                if (pg == 0) pool_diff_run<2>(PROJ, DB, row0, ch); else if (pg == 1) pool_diff_run<4>(PROJ, DB, row0, ch);
                else if (pg == 2) pool_diff_run<8>(PROJ, DB, row0, ch); else pool_diff_run<16>(PROJ, DB, row0, ch); }
#pragma unroll
            for (int q = 0; q < 8; ++q) asm volatile("" :: "v"(wm[q]));
            asm volatile("s_waitcnt vmcnt(0)" ::: "memory");
            __syncthreads();
            pg8::Gemm g{DB, PMT, 1024, 256, 256}; pg8::SchedPool S{G, bx};
            pg8::EpiPool E{A12, ZPF, pool_scale};
            pg8::gemm_phase<pg8::EpiPool, pg8::SchedPool, false>(lds, g, S, E);
            __syncthreads();
        }
        if (!(args.flags & 1)) {
            const int u0 = has_pool ? bx * 4 : 512 + (bx - 128) * 8, nu = has_pool ? 4 : 8;
            attn_phase(lds, QKVH, ropec, ropes, q_gain, k_gain, OB, LSE, u0, nu, args.flags);
        }
    }
    SEAM(2);

    if (IN(3)) {
        for (int rb = bx * 16; rb < M; rb += G * 16) mix_rows<4>(OB, LSE, PROJ, A12, rb);
    }
    SEAM(3);

    if (IN(4)) {
        pg8::Gemm g{A12, W12T, 2048, 2048, 1024}; pg8::SchedDual S{M / 256, DM / 256, G, bx};
        pg8::EpiGate E{MG, GF};
        pg8::gemm_phase<pg8::EpiGate, pg8::SchedDual, true>(lds, g, S, E);
    }
    SEAM(4);

    if (IN(5)) {
        pg8::Gemm g{MG, WoT, 2048, 2048, 2048}; pg8::SchedStd S{M / 256, DM / 256, G, bx};
        pg8::EpiRes E{x, args.out};
        pg8::gemm_phase<pg8::EpiRes, pg8::SchedStd, false>(lds, g, S, E);
    }
#undef IN
#undef SEAM
}

extern "C" void kernel_launch(void* const* d_in, const int* in_sizes, int n_in, void* d_out, int out_size, void* d_ws, size_t ws_size, hipStream_t stream) {
    static int grid = 0;
    if (grid == 0) {
        if (n_in != 11 || ws_size < WS_END) { fprintf(stderr, "kernel_launch: unexpected problem (n_in %d, ws %zu)\n", n_in, ws_size); grid = -1; return; }
        int dev = 0, cus = 0, per_cu = 0;
        hipGetDevice(&dev); hipDeviceGetAttribute(&cus, hipDeviceAttributeMultiprocessorCount, dev);
        if (hipFuncSetAttribute((const void*)fwd_kernel, hipFuncAttributeMaxDynamicSharedMemorySize, LDS_BYTES) != hipSuccess) { fprintf(stderr, "kernel_launch: hipFuncSetAttribute failed\n"); grid = -1; return; }
        if (hipOccupancyMaxActiveBlocksPerMultiprocessor(&per_cu, (const void*)fwd_kernel, NTHREADS, LDS_BYTES) != hipSuccess || per_cu < 1) { fprintf(stderr, "kernel_launch: occupancy query says %d\n", per_cu); per_cu = 1; }
        (void)hipGetLastError();
        grid = cus;
        if (grid != 256) { fprintf(stderr, "kernel_launch: built for a 256-CU device (work split over exactly 256 workgroups), found %d CUs; nothing launched\n", cus); grid = -1; return; }
        fprintf(stderr, "kernel_launch: grid %d (per_cu %d)\n", grid, per_cu);
    }
    if (grid < 0) return;
    if (hipMemsetAsync((char*)d_ws + WS_CTL, 0, 65536, stream) != hipSuccess) { fprintf(stderr, "kernel_launch: memset failed\n"); return; }
    Args a{};
    for (int i = 0; i < 11; ++i) a.in[i] = (const float*)d_in[i];
    a.out = (float*)d_out; a.ws = (unsigned char*)d_ws;
#if MK_N_LAUNCHES == 1
    a.ph_lo = 0; a.ph_hi = 6;
    void* kargs[] = {&a};
    hipError_t e = hipLaunchCooperativeKernel((const void*)fwd_kernel, dim3(grid), dim3(NTHREADS), kargs, LDS_BYTES, stream);
    if (e != hipSuccess) fprintf(stderr, "cooperative launch failed: %s (grid %d)\n", hipGetErrorString(e), grid);
#if PROBE_PHASE >= 0
    a.ph_lo = PROBE_PHASE; a.ph_hi = PROBE_PHASE + 1; a.flags = PROBE_FLAGS; for (int rep = 0; rep < PROBE_REPS; ++rep) hipLaunchKernelGGL(fwd_kernel, dim3(grid), dim3(NTHREADS), LDS_BYTES, stream, a);
#endif
#else
    for (int p = 0; p < 6; ++p) { a.ph_lo = p; a.ph_hi = p + 1; hipLaunchKernelGGL(fwd_kernel, dim3(grid), dim3(NTHREADS), LDS_BYTES, stream, a); }
#endif
}
```
